# Optimizing an MI355X kernel written in HIP

```python
import jax, jax.numpy as jnp
from jax import lax
import numpy as np

D_MODEL = 1024
BATCH = 4
SEQ = 8192
DEPTH = 4

N_MIXERS = 3
EXPAND = 2
D_INNER = EXPAND * D_MODEL
CHUNK = 128
A_GROUPS = 8
A_GROUP_DIM = D_INNER // A_GROUPS
POOL_WINDOWS = (2, 4, 8, 16)
B_GROUPS = len(POOL_WINDOWS)
B_GROUP_DIM = D_INNER // B_GROUPS
CONV_WIDTH = 3
LN_EPS = 1e-5
ALPHA = (2.0 * DEPTH) ** 0.25
BETA = (8.0 * DEPTH) ** -0.25

kernel_name = "hybrid_gmlp_pool_shortconv_deepnorm"


def layer_norm(x, g, b):
    xf = x.astype(jnp.float32)
    mu = jnp.mean(xf, axis=-1, keepdims=True)
    var = jnp.mean(jnp.square(xf - mu), axis=-1, keepdims=True)
    y = (xf - mu) * lax.rsqrt(var + LN_EPS)
    return (y * g.astype(jnp.float32) + b.astype(jnp.float32)).astype(x.dtype)


def mixer_a(h, w_in, v_gain, v_bias, w_s, b_s, w_out):
    bsz, s, _ = h.shape
    u, v, z = jnp.split(h @ w_in, 3, axis=-1)
    u = jax.nn.gelu(u)
    v = layer_norm(jax.nn.gelu(v), v_gain, v_bias)
    v = v.reshape(bsz, s // CHUNK, CHUNK, A_GROUPS, A_GROUP_DIM)
    w_causal = w_s * jnp.tril(jnp.ones((CHUNK, CHUNK), w_s.dtype))
    sv = jnp.einsum('gts,bcsgd->bctgd', w_causal, v) + b_s.T[:, :, None]
    sv = sv.reshape(bsz, s, D_INNER)
    return (u * sv * jax.nn.silu(z)) @ w_out


def trailing_mean_minus_self(v, window):
    s = v.shape[1]
    vf = v.astype(jnp.float32)
    csum = jnp.cumsum(vf, axis=1)
    lag = jnp.pad(csum, ((0, 0), (window, 0), (0, 0)))[:, :s]
    count = jnp.minimum(jnp.arange(1, s + 1), window).astype(jnp.float32)[None, :, None]
    return ((csum - lag) / count - vf).astype(v.dtype)


def mixer_b(h, w_in, w_grp, scale, w_out):
    bsz, s, _ = h.shape
    v, z = jnp.split(h @ w_in, 2, axis=-1)
    groups = jnp.split(v, B_GROUPS, axis=-1)
    pooled = jnp.stack([trailing_mean_minus_self(g, w) for g, w in zip(groups, POOL_WINDOWS)], axis=2)
    mixed = jnp.einsum('bsgd,gde->bsge', pooled, w_grp).reshape(bsz, s, D_INNER)
    return (mixed * scale * jax.nn.silu(z)) @ w_out


def causal_depthwise_conv(x, w):
    k = w.shape[0]
    s = x.shape[1]
    xp = jnp.pad(x, ((0, 0), (k - 1, 0), (0, 0)))
    out = xp[:, 0:s] * w[0]
    for j in range(1, k):
        out = out + xp[:, j:j + s] * w[j]
    return out


def mixer_c(h, w_in, conv_w, w_out):
    b_gate, c_gate, hv, z = jnp.split(h @ w_in, 4, axis=-1)
    y = b_gate * causal_depthwise_conv(c_gate * hv, conv_w)
    return (y * jax.nn.silu(z)) @ w_out


def _dense(key, fan_in, fan_out, scale=1.0):
    return jax.random.normal(key, (fan_in, fan_out), jnp.float32) * (scale * fan_in ** -0.5)


def _gain(key, n):
    return 1.0 + 0.1 * jax.random.normal(key, (n,), jnp.float32)


def _bias(key, n):
    return 0.02 * jax.random.normal(key, (n,), jnp.float32)


def setup_inputs(seed: int = 0) -> dict:
    key = jax.random.key(seed)
    keys = jax.random.split(key, 1 + DEPTH)
    params = {"x": jax.random.normal(keys[0], (BATCH, SEQ, D_MODEL), jnp.float32)}
    tags = ("a", "b", "c")
    for i in range(DEPTH):
        kind = i % N_MIXERS
        p = tags[kind] + str(i)
        k = jax.random.split(keys[1 + i], 8)
        if kind == 0:
            params[p + "_w_in"] = _dense(k[0], D_MODEL, 3 * D_INNER)
            params[p + "_v_gain"] = _gain(k[1], D_INNER)
            params[p + "_v_bias"] = _bias(k[2], D_INNER)
            params[p + "_w_s"] = jax.random.normal(k[3], (A_GROUPS, CHUNK, CHUNK), jnp.float32) * CHUNK ** -0.5
            params[p + "_b_s"] = 1.0 + 0.1 * jax.random.normal(k[4], (A_GROUPS, CHUNK), jnp.float32)
            params[p + "_w_out"] = _dense(k[5], D_INNER, D_MODEL, BETA)
        elif kind == 1:
            params[p + "_w_in"] = _dense(k[0], D_MODEL, 2 * D_INNER)
            params[p + "_w_grp"] = jax.random.normal(k[1], (B_GROUPS, B_GROUP_DIM, B_GROUP_DIM), jnp.float32) * B_GROUP_DIM ** -0.5
            params[p + "_scale"] = _gain(k[2], D_INNER)
            params[p + "_w_out"] = _dense(k[3], D_INNER, D_MODEL, BETA)
        else:
            params[p + "_w_in"] = _dense(k[0], D_MODEL, 4 * D_INNER)
            params[p + "_conv_w"] = jax.random.normal(k[1], (CONV_WIDTH, D_INNER), jnp.float32) * CONV_WIDTH ** -0.5
            params[p + "_w_out"] = _dense(k[2], D_INNER, D_MODEL, BETA)
        params["ln" + str(i) + "_gain"] = _gain(k[6], D_MODEL)
        params["ln" + str(i) + "_bias"] = _bias(k[7], D_MODEL)
    return params


def reference(x,
              a0_w_in, a0_v_gain, a0_v_bias, a0_w_s, a0_b_s, a0_w_out, ln0_gain, ln0_bias,
              b1_w_in, b1_w_grp, b1_scale, b1_w_out, ln1_gain, ln1_bias,
              c2_w_in, c2_conv_w, c2_w_out, ln2_gain, ln2_bias,
              a3_w_in, a3_v_gain, a3_v_bias, a3_w_s, a3_b_s, a3_w_out, ln3_gain, ln3_bias):
    mixers = (mixer_a, mixer_b, mixer_c)
    layer_params = [
        (a0_w_in, a0_v_gain, a0_v_bias, a0_w_s, a0_b_s, a0_w_out),
        (b1_w_in, b1_w_grp, b1_scale, b1_w_out),
        (c2_w_in, c2_conv_w, c2_w_out),
        (a3_w_in, a3_v_gain, a3_v_bias, a3_w_s, a3_b_s, a3_w_out),
    ]
    norm_params = [(ln0_gain, ln0_bias), (ln1_gain, ln1_bias), (ln2_gain, ln2_bias), (ln3_gain, ln3_bias)]
    for i in range(DEPTH):
        mixer = mixers[i % N_MIXERS]
        g, b = norm_params[i]
        x = layer_norm(ALPHA * x + mixer(x, *layer_params[i]), g, b)
    return x
```

```cpp
#include <hip/hip_runtime.h>
#include <hip/hip_cooperative_groups.h>
#include <cstdio>
namespace cg = cooperative_groups;

#ifndef MK_MULTI
#define MK_MULTI 0
#endif

#define LAS __attribute__((address_space(3)))
typedef unsigned short bf16_t;
typedef short bf16x8 __attribute__((ext_vector_type(8)));
typedef short s16x4 __attribute__((ext_vector_type(4)));
typedef float f32x4 __attribute__((ext_vector_type(4)));
typedef float f32x2 __attribute__((ext_vector_type(2)));
typedef unsigned u32x4 __attribute__((ext_vector_type(4)));
typedef unsigned u32x2 __attribute__((ext_vector_type(2)));

constexpr int DM = 1024, DI = 2048, SEQ = 8192, MTOK = 4 * SEQ;
constexpr float LN_EPS = 1e-5f;
constexpr float ALPHA = 1.6817928305074292f;

constexpr int BM = 256, BK = 64, HALF = 128, HTB = HALF * BK * 2  , STAGE_BYTES = 8 * HTB, NXCD = 8, WGM = 8;
constexpr int LDS_BYTES = 147456;

constexpr size_t MiB = 1u << 20;
constexpr size_t WS_STATS = 1 * MiB;
constexpr size_t WS_WSB = 9 * MiB, WS_RSUM = 10 * MiB;
constexpr size_t WS_W = 16 * MiB;
constexpr size_t W_A_IN = 0, W_A_OUT = 12 * MiB, W_A_SZ = 16 * MiB;
constexpr size_t WS_WA0 = WS_W, WS_WB = WS_WA0 + W_A_SZ, WS_WB_GRP = WS_WB + 8 * MiB, WS_WB_OUT = WS_WB + 10 * MiB, WS_WC = WS_WB + 14 * MiB, WS_WC_OUT = WS_WC + 16 * MiB, WS_WA3 = WS_WC + 20 * MiB;
constexpr size_t WS_XB = WS_WA3 + W_A_SZ;
constexpr size_t WS_BUFC = WS_XB;
constexpr size_t WS_BUFA = WS_XB + 128 * MiB;
constexpr size_t WS_BUFB = WS_BUFA + 128 * MiB;
constexpr size_t WS_END = WS_BUFB + 128 * MiB;
static_assert(WS_XB == 82 * MiB, "ws map");

__device__ __forceinline__ unsigned cvt_pk_bf16(float lo, float hi) { unsigned r; asm volatile("v_cvt_pk_bf16_f32 %0, %1, %2" : "=v"(r) : "v"(lo), "v"(hi)); return r; }
__device__ __forceinline__ float bf_lo(unsigned w) { return __uint_as_float(w << 16); }
__device__ __forceinline__ float bf_hi(unsigned w) { return __uint_as_float(w & 0xffff0000u); }
__device__ __forceinline__ float sigmoid_f(float x) { return __builtin_amdgcn_rcpf(1.0f + __builtin_amdgcn_exp2f(-1.4426950408889634f * x)); }
__device__ __forceinline__ float silu_f(float x) { return x * sigmoid_f(x); }
__device__ __forceinline__ float gelu_f(float x) { return x * sigmoid_f(1.5957691216057308f * x * (1.0f + 0.044715f * x * x)); }

__host__ __device__ __forceinline__ int lds_byte(int r, int c) { const int st = (r >> 4) * 2 + (c >> 5), rr = r & 15, cc = c & 31, ob = rr * 64 + cc * 2; return st * 1024 + (ob ^ (((ob >> 9) & 1) << 5)); }
__host__ __device__ __forceinline__ void stage_rc(int b, int& R, int& C) { const int st = b / 1024, sb = b % 1024, swz = sb ^ (((sb >> 9) & 1) << 5); R = (st >> 1) * 16 + swz / 64; C = (st & 1) * 32 + (swz % 64) / 2; }
__host__ __device__ __forceinline__ int perm32(int rho) { const int n = rho >> 4, i = rho & 15; return 8 * (i >> 2) + 4 * n + (i & 3); }

struct Unit { int pm, pn, aoff; };
struct Gemm { const bf16_t* A; const bf16_t* Bt; int lda, ldb, K; };

template <bool GRP> struct StaticOrder {
    int nM, nN, nwg, G, c;
    __device__ void init(int M, int N, int G_, int c_) { nM = M / BM; nN = N / BM; nwg = nM * nN; G = G_; c = c_; }
    __device__ bool next(int i, Unit& u) const {
        const long L = (long)i * G + c; if (L >= nwg) return false;
        int wgid = (int)L; { const int q = nwg / NXCD, r = nwg % NXCD, xcd = wgid % NXCD, off = wgid / NXCD; wgid = (xcd < r ? xcd * (q + 1) : r * (q + 1) + (xcd - r) * q) + off; }
        const int nig = WGM * nN, gid = wgid / nig, fm = gid * WGM, gsz = (nM - fm) < WGM ? (nM - fm) : WGM;
        u.pm = fm + ((wgid % nig) % gsz); u.pn = (wgid % nig) / gsz; u.aoff = GRP ? (u.pn >> 1) * 1024 : 0; return true;
    }
    __device__ __forceinline__ void a_ready(const Unit&) const {}
    __device__ __forceinline__ void done(const Unit&) const {}
};

template <class Epi, class Sched>
__device__ __forceinline__ void gemm_phase(LAS unsigned char* lds, const Gemm g, const Sched& S, const Epi& E, const int tid_in) {
    const int tid = tid_in, wid = __builtin_amdgcn_readfirstlane(tid >> 6), lane = tid & 63, wr = wid >> 2, wc = wid & 3, fr = lane & 15, fq = lane >> 4;
    const int K = g.K, nt = K / BK;
#define PG8_STAMP() do {} while (0)
    PG8_STAMP();
    unsigned voffA[2], voffB[2];
#pragma unroll
    for (int i = 0; i < 2; ++i) { int R, C; stage_rc(tid * 16 + i * 8192, R, C); const int Rb = Epi::PERM ? ((R & ~31) + perm32(R & 31)) : R;
        voffA[i] = (unsigned)(R * g.lda + C) * 2u; voffB[i] = (unsigned)(Rb * g.ldb + C) * 2u; }
    const size_t kstep = (size_t)(BK * 2);
    const size_t hstepA = (size_t)HALF * g.lda * 2, hstepB = (size_t)HALF * g.ldb * 2;
    const size_t tstepA = 2 * hstepA, tstepB = 2 * hstepB;
    const unsigned ldsw = (unsigned)wid * 1024u;
    const int aoff = lds_byte(wr * 64 + fr, fq * 8), boff = lds_byte(wc * 32 + fr, fq * 8);
#define PG8_SA(b, h) (((b) * 2 + (h)) * HTB)
#define PG8_SB(b, h) ((4 + (b) * 2 + (h)) * HTB)
#define PG8_STAGE(bufoff, gbase, voff) do { _Pragma("unroll") for (int _i = 0; _i < 2; ++_i) \
        __builtin_amdgcn_global_load_lds((const unsigned*)((const char*)(gbase) + (voff)[_i]), (LAS unsigned*)(lds + (bufoff) + ldsw + _i * 8192), 16, 0, 0); } while (0)
#define PG8_LDA(dst, b, h) do { _Pragma("unroll") for (int m = 0; m < 4; ++m) _Pragma("unroll") for (int k = 0; k < 2; ++k) dst[m][k] = *(const LAS bf16x8*)(lds + PG8_SA(b, h) + aoff + m * 2048 + k * 1024); } while (0)
#define PG8_LDB(dst, b, h) do { _Pragma("unroll") for (int n = 0; n < 2; ++n) _Pragma("unroll") for (int k = 0; k < 2; ++k) dst[n][k] = *(const LAS bf16x8*)(lds + PG8_SB(b, h) + boff + n * 2048 + k * 1024); } while (0)
#define PG8_MMA(ai, bj, At, Bt) do { __builtin_amdgcn_s_setprio(1); _Pragma("unroll") for (int m = 0; m < 4; ++m) _Pragma("unroll") for (int n = 0; n < 2; ++n) _Pragma("unroll") for (int k = 0; k < 2; ++k) \
        acc[ai][bj][m][n] = __builtin_amdgcn_mfma_f32_16x16x32_bf16(Bt[n][k], At[m][k], acc[ai][bj][m][n], 0, 0, 0); __builtin_amdgcn_s_setprio(0); } while (0)
#define PG8_WAIT_V(n) asm volatile("s_waitcnt vmcnt(" #n ")" ::: "memory")
#define PG8_WAIT_L(n) asm volatile("s_waitcnt lgkmcnt(" #n ")" ::: "memory")
#define PG8_BAR __builtin_amdgcn_s_barrier()
#define PG8_SCHED __builtin_amdgcn_sched_barrier(0)
    Unit cur, nxt; int ui = 0;
    if (!S.next(0, cur)) return;
    f32x4 acc[2][2][4][2];
#pragma unroll
    for (int a = 0; a < 2; ++a)
#pragma unroll
        for (int b = 0; b < 2; ++b)
#pragma unroll
            for (int m = 0; m < 4; ++m)
#pragma unroll
                for (int n = 0; n < 2; ++n) acc[a][b][m][n] = (f32x4){0.f, 0.f, 0.f, 0.f};
    bf16x8 At[4][2], B0[2][2], B1[2][2];
    const char* cA = (const char*)g.A + cur.aoff + (size_t)cur.pm * tstepA; const char* cB = (const char*)g.Bt + (size_t)cur.pn * tstepB;
    S.a_ready(cur);
    PG8_STAGE(PG8_SB(0, 0), cB, voffB); PG8_STAGE(PG8_SA(0, 0), cA, voffA); PG8_STAGE(PG8_SB(0, 1), cB + hstepB, voffB); PG8_STAGE(PG8_SA(0, 1), cA + hstepA, voffA);
    if (wr == 1) PG8_BAR;
    PG8_WAIT_V(4); PG8_BAR;
    PG8_STAGE(PG8_SB(1, 0), cB + kstep, voffB); PG8_STAGE(PG8_SA(1, 0), cA + kstep, voffA); PG8_STAGE(PG8_SB(1, 1), cB + hstepB + kstep, voffB);
    PG8_WAIT_V(6); PG8_BAR;
    PG8_STAMP();
    for (;;) {
        const bool has_next = S.next(ui + 1, nxt);
        const char* nA = has_next ? (const char*)g.A + nxt.aoff + (size_t)nxt.pm * tstepA : cA; const char* nB = has_next ? (const char*)g.Bt + (size_t)nxt.pn * tstepB : cB;
        for (int t = 0; t < nt; t += 2) {
            const bool last = (t == nt - 2);
            const char* a1 = cA + (size_t)(t + 1) * kstep;
            const char* a2 = last ? nA : cA + (size_t)(t + 2) * kstep; const char* b2 = last ? nB : cB + (size_t)(t + 2) * kstep;
            const char* a3 = a2 + kstep; const char* b3 = b2 + kstep;
            if (last && has_next) S.a_ready(nxt);
            PG8_LDB(B0, 0, 0); PG8_SCHED; PG8_LDA(At, 0, 0); PG8_STAGE(PG8_SA(1, 1), a1 + hstepA, voffA);
            PG8_WAIT_L(8); PG8_BAR; PG8_WAIT_L(0); PG8_MMA(0, 0, At, B0); PG8_BAR; PG8_SCHED;
            PG8_LDB(B1, 0, 1); PG8_STAGE(PG8_SB(0, 0), b2, voffB);
            PG8_BAR; PG8_WAIT_L(0); PG8_MMA(0, 1, At, B1); PG8_BAR;
            PG8_LDA(At, 0, 1); PG8_STAGE(PG8_SA(0, 0), a2, voffA);
            PG8_BAR; PG8_WAIT_L(0); PG8_MMA(1, 0, At, B0); PG8_BAR; PG8_SCHED;
            PG8_STAGE(PG8_SB(0, 1), b2 + hstepB, voffB);
            PG8_WAIT_V(6); PG8_BAR; PG8_MMA(1, 1, At, B1); PG8_BAR;
            PG8_LDB(B0, 1, 0); PG8_SCHED; PG8_LDA(At, 1, 0); PG8_STAGE(PG8_SA(0, 1), a2 + hstepA, voffA);
            PG8_WAIT_L(8); PG8_BAR; PG8_WAIT_L(0); PG8_MMA(0, 0, At, B0); PG8_BAR; PG8_SCHED;
            PG8_LDB(B1, 1, 1); PG8_STAGE(PG8_SB(1, 0), b3, voffB);
            PG8_BAR; PG8_WAIT_L(0); PG8_MMA(0, 1, At, B1); PG8_BAR;
            PG8_LDA(At, 1, 1); PG8_STAGE(PG8_SA(1, 0), a3, voffA);
            PG8_BAR; PG8_WAIT_L(0); PG8_MMA(1, 0, At, B0); PG8_BAR; PG8_SCHED;
            PG8_STAGE(PG8_SB(1, 1), b3 + hstepB, voffB);
            PG8_WAIT_V(6); PG8_BAR; PG8_MMA(1, 1, At, B1); PG8_BAR;
        }
        PG8_STAMP();
        if constexpr (!Epi::AFTER_DRAIN) { E(acc, cur, wr, wc, fr, fq); S.done(cur); }
        PG8_STAMP();
        if (!has_next) break;
#pragma unroll
        for (int a = 0; a < 2; ++a)
#pragma unroll
            for (int b = 0; b < 2; ++b)
#pragma unroll
                for (int m = 0; m < 4; ++m)
#pragma unroll
                    for (int n = 0; n < 2; ++n) acc[a][b][m][n] = (f32x4){0.f, 0.f, 0.f, 0.f};
        cur = nxt; cA = nA; cB = nB; ++ui;
    }
    PG8_WAIT_V(0);
    if (wr == 0) PG8_BAR;
    PG8_BAR;
    if constexpr (Epi::AFTER_DRAIN) { E.fused(acc, cur, wr, wc, fr, fq, lds, wid, lane); S.done(cur); }
    PG8_STAMP();
#undef PG8_STAMP
#undef PG8_SA
#undef PG8_SB
#undef PG8_STAGE
#undef PG8_LDA
#undef PG8_LDB
#undef PG8_MMA
#undef PG8_WAIT_V
#undef PG8_WAIT_L
#undef PG8_BAR
#undef PG8_SCHED
}

struct EpiA1 {
    static constexpr bool PERM = true, AFTER_DRAIN = false;
    bf16_t* P; bf16_t* GV; f32x2* stats;
    __device__ __forceinline__ void operator()(const f32x4 (&acc)[2][2][4][2], const Unit& u, int wr, int wc, int fr, int fq) const {
        const int row0 = u.pm * BM + wr * 64 + fr;
        if (u.pn < 16) {
            const int col0 = u.pn * 128 + wc * 32 + 8 * fq;
#pragma unroll
            for (int ai = 0; ai < 2; ++ai)
#pragma unroll
                for (int m = 0; m < 4; ++m) {
                    const f32x4 u0 = acc[ai][0][m][0], u1 = acc[ai][0][m][1], z0 = acc[ai][1][m][0], z1 = acc[ai][1][m][1];
                    u32x4 w;
                    w.x = cvt_pk_bf16(gelu_f(u0[0]) * silu_f(z0[0]), gelu_f(u0[1]) * silu_f(z0[1]));
                    w.y = cvt_pk_bf16(gelu_f(u0[2]) * silu_f(z0[2]), gelu_f(u0[3]) * silu_f(z0[3]));
                    w.z = cvt_pk_bf16(gelu_f(u1[0]) * silu_f(z1[0]), gelu_f(u1[1]) * silu_f(z1[1]));
                    w.w = cvt_pk_bf16(gelu_f(u1[2]) * silu_f(z1[2]), gelu_f(u1[3]) * silu_f(z1[3]));
                    *(u32x4*)(P + (size_t)(row0 + ai * HALF + m * 16) * DI + col0) = w;
                }
        } else {
            const int pv = u.pn - 16, col0 = pv * 256 + wc * 32 + 8 * fq;
#pragma unroll
            for (int ai = 0; ai < 2; ++ai)
#pragma unroll
                for (int m = 0; m < 4; ++m) {
                    const int row = row0 + ai * HALF + m * 16; float s = 0.f, s2 = 0.f;
#pragma unroll
                    for (int bj = 0; bj < 2; ++bj) {
                        const f32x4 v0 = acc[ai][bj][m][0], v1 = acc[ai][bj][m][1];
                        u32x4 w;
                        w.x = cvt_pk_bf16(gelu_f(v0[0]), gelu_f(v0[1])); w.y = cvt_pk_bf16(gelu_f(v0[2]), gelu_f(v0[3]));
                        w.z = cvt_pk_bf16(gelu_f(v1[0]), gelu_f(v1[1])); w.w = cvt_pk_bf16(gelu_f(v1[2]), gelu_f(v1[3]));
                        *(u32x4*)(GV + (size_t)row * DI + col0 + bj * HALF) = w;
#pragma unroll
                        for (int j = 0; j < 4; ++j) { const float a = bf_lo(w[j]), b = bf_hi(w[j]); s += a + b; s2 += a * a + b * b; }
                    }
                    s += __shfl_xor(s, 16); s += __shfl_xor(s, 32); s2 += __shfl_xor(s2, 16); s2 += __shfl_xor(s2, 32);
                    if (fq == 0) stats[(size_t)row * 32 + pv * 4 + wc] = (f32x2){s, s2};
                }
        }
    }
};
struct EpiB1 {
    static constexpr bool PERM = true, AFTER_DRAIN = false;
    bf16_t* V; bf16_t* SZ; const float* scale;
    __device__ __forceinline__ void operator()(const f32x4 (&acc)[2][2][4][2], const Unit& u, int wr, int wc, int fr, int fq) const {
        const int row0 = u.pm * BM + wr * 64 + fr;
        if (u.pn < 8) {
            const int col0 = u.pn * 256 + wc * 32 + 8 * fq;
#pragma unroll
            for (int ai = 0; ai < 2; ++ai)
#pragma unroll
                for (int m = 0; m < 4; ++m)
#pragma unroll
                    for (int bj = 0; bj < 2; ++bj) {
                        const f32x4 v0 = acc[ai][bj][m][0], v1 = acc[ai][bj][m][1]; u32x4 w;
                        w.x = cvt_pk_bf16(v0[0], v0[1]); w.y = cvt_pk_bf16(v0[2], v0[3]); w.z = cvt_pk_bf16(v1[0], v1[1]); w.w = cvt_pk_bf16(v1[2], v1[3]);
                        *(u32x4*)(V + (size_t)(row0 + ai * HALF + m * 16) * DI + col0 + bj * HALF) = w;
                    }
        } else {
            const int col0 = (u.pn - 8) * 256 + wc * 32 + 8 * fq;
            f32x4 sc[2][2];
#pragma unroll
            for (int bj = 0; bj < 2; ++bj) { sc[bj][0] = *(const f32x4*)(scale + col0 + bj * HALF); sc[bj][1] = *(const f32x4*)(scale + col0 + bj * HALF + 4); }
#pragma unroll
            for (int ai = 0; ai < 2; ++ai)
#pragma unroll
                for (int m = 0; m < 4; ++m)
#pragma unroll
                    for (int bj = 0; bj < 2; ++bj) {
                        const f32x4 z0 = acc[ai][bj][m][0], z1 = acc[ai][bj][m][1]; u32x4 w;
                        w.x = cvt_pk_bf16(silu_f(z0[0]) * sc[bj][0][0], silu_f(z0[1]) * sc[bj][0][1]); w.y = cvt_pk_bf16(silu_f(z0[2]) * sc[bj][0][2], silu_f(z0[3]) * sc[bj][0][3]);
                        w.z = cvt_pk_bf16(silu_f(z1[0]) * sc[bj][1][0], silu_f(z1[1]) * sc[bj][1][1]); w.w = cvt_pk_bf16(silu_f(z1[2]) * sc[bj][1][2], silu_f(z1[3]) * sc[bj][1][3]);
                        *(u32x4*)(SZ + (size_t)(row0 + ai * HALF + m * 16) * DI + col0 + bj * HALF) = w;
                    }
        }
    }
};
struct EpiBgrp {
    static constexpr bool PERM = true, AFTER_DRAIN = false;
    bf16_t* R;
    __device__ __forceinline__ void operator()(const f32x4 (&acc)[2][2][4][2], const Unit& u, int wr, int wc, int fr, int fq) const {
        const int row0 = u.pm * BM + wr * 64 + fr, col0 = u.pn * 256 + wc * 32 + 8 * fq;
#pragma unroll
        for (int ai = 0; ai < 2; ++ai)
#pragma unroll
            for (int m = 0; m < 4; ++m)
#pragma unroll
                for (int bj = 0; bj < 2; ++bj) {
                    bf16_t* p = R + (size_t)(row0 + ai * HALF + m * 16) * DI + col0 + bj * HALF;
                    const u32x4 s = *(const u32x4*)p; const f32x4 v0 = acc[ai][bj][m][0], v1 = acc[ai][bj][m][1]; u32x4 w;
                    w.x = cvt_pk_bf16(v0[0] * bf_lo(s.x), v0[1] * bf_hi(s.x)); w.y = cvt_pk_bf16(v0[2] * bf_lo(s.y), v0[3] * bf_hi(s.y));
                    w.z = cvt_pk_bf16(v1[0] * bf_lo(s.z), v1[1] * bf_hi(s.z)); w.w = cvt_pk_bf16(v1[2] * bf_lo(s.w), v1[3] * bf_hi(s.w));
                    *(u32x4*)p = w;
                }
    }
};
struct EpiC1 {
    static constexpr bool PERM = true, AFTER_DRAIN = false;
    bf16_t* MB; bf16_t* BZ;
    __device__ __forceinline__ void operator()(const f32x4 (&acc)[2][2][4][2], const Unit& u, int wr, int wc, int fr, int fq) const {
        const int row0 = u.pm * BM + wr * 64 + fr;
        if (u.pn < 16) {
            const int col0 = u.pn * 128 + wc * 32 + 8 * fq;
#pragma unroll
            for (int ai = 0; ai < 2; ++ai)
#pragma unroll
                for (int m = 0; m < 4; ++m) {
                    const f32x4 a0 = acc[ai][0][m][0], a1 = acc[ai][0][m][1], b0 = acc[ai][1][m][0], b1 = acc[ai][1][m][1]; u32x4 w;
                    w.x = cvt_pk_bf16(a0[0] * b0[0], a0[1] * b0[1]); w.y = cvt_pk_bf16(a0[2] * b0[2], a0[3] * b0[3]);
                    w.z = cvt_pk_bf16(a1[0] * b1[0], a1[1] * b1[1]); w.w = cvt_pk_bf16(a1[2] * b1[2], a1[3] * b1[3]);
                    *(u32x4*)(MB + (size_t)(row0 + ai * HALF + m * 16) * DI + col0) = w;
                }
        } else {
            const int col0 = (u.pn - 16) * 128 + wc * 32 + 8 * fq;
#pragma unroll
            for (int ai = 0; ai < 2; ++ai)
#pragma unroll
                for (int m = 0; m < 4; ++m) {
                    const f32x4 a0 = acc[ai][0][m][0], a1 = acc[ai][0][m][1], z0 = acc[ai][1][m][0], z1 = acc[ai][1][m][1]; u32x4 w;
                    w.x = cvt_pk_bf16(a0[0] * silu_f(z0[0]), a0[1] * silu_f(z0[1])); w.y = cvt_pk_bf16(a0[2] * silu_f(z0[2]), a0[3] * silu_f(z0[3]));
                    w.z = cvt_pk_bf16(a1[0] * silu_f(z1[0]), a1[1] * silu_f(z1[1])); w.w = cvt_pk_bf16(a1[2] * silu_f(z1[2]), a1[3] * silu_f(z1[3]));
                    *(u32x4*)(BZ + (size_t)(row0 + ai * HALF + m * 16) * DI + col0) = w;
                }
        }
    }
};
struct EpiG2 {
    static constexpr bool PERM = false, AFTER_DRAIN = false;
    const float* X; float* Y;
    __device__ __forceinline__ void operator()(const f32x4 (&acc)[2][2][4][2], const Unit& u, int wr, int wc, int fr, int fq) const {
        const int row0 = u.pm * BM + wr * 64 + fr, col0 = u.pn * BM + wc * 32 + 4 * fq;
#pragma unroll
        for (int ai = 0; ai < 2; ++ai)
#pragma unroll
            for (int m = 0; m < 4; ++m) { const size_t off = (size_t)(row0 + ai * HALF + m * 16) * DM + col0;
#pragma unroll
                for (int bj = 0; bj < 2; ++bj)
#pragma unroll
                    for (int n = 0; n < 2; ++n) { const f32x4 xv = *(const f32x4*)(X + off + bj * HALF + n * 16); *(f32x4*)(Y + off + bj * HALF + n * 16) = acc[ai][bj][m][n] + ALPHA * xv; }
                asm volatile("" ::: "memory"); }
    }
};

__device__ __forceinline__ float wave_sum(float v) {
#pragma unroll
    for (int o = 1; o < 64; o <<= 1) v += __shfl_xor(v, o);
    return v;
}
__device__ __forceinline__ void ln_phase(const float* Y, const float* gain, const float* bias, float* X, bf16_t* XB, bool write_xb, int tid, int bid, int G) {
    const int lane = tid & 63, wid = tid >> 6, gw = bid * 8 + wid, NGW = G * 8;
    f32x4 g[4], b[4];
#pragma unroll
    for (int j = 0; j < 4; ++j) { g[j] = *((const f32x4*)gain + lane + 64 * j); b[j] = *((const f32x4*)bias + lane + 64 * j); }
    for (int m = gw; m < MTOK; m += NGW) {
        const f32x4* yr = (const f32x4*)(Y + (size_t)m * DM) + lane;
        f32x4 v[4]; float s = 0.f;
#pragma unroll
        for (int j = 0; j < 4; ++j) { v[j] = yr[64 * j]; s += (v[j].x + v[j].y) + (v[j].z + v[j].w); }
        const float mean = wave_sum(s) * (1.f / DM); float s2 = 0.f;
#pragma unroll
        for (int j = 0; j < 4; ++j) { v[j] = v[j] - mean; s2 += (v[j].x * v[j].x + v[j].y * v[j].y) + (v[j].z * v[j].z + v[j].w * v[j].w); }
        const float rstd = 1.0f / sqrtf(wave_sum(s2) * (1.f / DM) + LN_EPS);
        f32x4* xr = (f32x4*)(X + (size_t)m * DM) + lane; u32x2* xb = (u32x2*)(XB + (size_t)m * DM) + lane;
#pragma unroll
        for (int j = 0; j < 4; ++j) { const f32x4 o = v[j] * rstd * g[j] + b[j]; xr[64 * j] = o;
            if (write_xb) xb[64 * j] = (u32x2){cvt_pk_bf16(o.x, o.y), cvt_pk_bf16(o.z, o.w)}; }
    }
}
__device__ __forceinline__ void unpack8(const u32x4 w, float (&f)[8]) { f[0] = bf_lo(w.x); f[1] = bf_hi(w.x); f[2] = bf_lo(w.y); f[3] = bf_hi(w.y); f[4] = bf_lo(w.z); f[5] = bf_hi(w.z); f[6] = bf_lo(w.w); f[7] = bf_hi(w.w); }
__device__ __forceinline__ u32x4 pack8(const float (&f)[8]) { u32x4 w; w.x = cvt_pk_bf16(f[0], f[1]); w.y = cvt_pk_bf16(f[2], f[3]); w.z = cvt_pk_bf16(f[4], f[5]); w.w = cvt_pk_bf16(f[6], f[7]); return w; }
__device__ __forceinline__ void pool_phase(const bf16_t* V, bf16_t* VP, int tid, int bid, int G) {
    const int NT = G * 512;
    for (int item = bid * 512 + tid; item < (MTOK / 32) * 256; item += NT) {
        const int c8 = (item & 255) * 8, t0 = (item >> 8) * 32, w = 2 << (c8 >> 9), ss = t0 & ~(SEQ - 1);
        float sum[8], f[8];
#pragma unroll
        for (int j = 0; j < 8; ++j) sum[j] = 0.f;
        for (int k = 1; k < w; ++k) { const int t = t0 - k; if (t >= ss) { unpack8(*(const u32x4*)(V + (size_t)t * DI + c8), f);
#pragma unroll
            for (int j = 0; j < 8; ++j) sum[j] += f[j]; } }
        for (int i = 0; i < 32; ++i) {
            const int t = t0 + i; unpack8(*(const u32x4*)(V + (size_t)t * DI + c8), f);
            const int cnt = (t - ss + 1) < w ? (t - ss + 1) : w; const float inv = 1.0f / (float)cnt; float o[8];
#pragma unroll
            for (int j = 0; j < 8; ++j) { sum[j] += f[j]; o[j] = sum[j] * inv - f[j]; }
            *(u32x4*)(VP + (size_t)t * DI + c8) = pack8(o);
            const int ts = t - w + 1;
            if (ts >= ss) { unpack8(*(const u32x4*)(V + (size_t)ts * DI + c8), f);
#pragma unroll
                for (int j = 0; j < 8; ++j) sum[j] -= f[j]; }
        }
    }
}
__device__ __forceinline__ void conv_phase(const bf16_t* MB, bf16_t* BZ, const float* cw, int tid, int bid, int G) {
    const int NT = G * 512;
    for (int item = bid * 512 + tid; item < (MTOK / 32) * 256; item += NT) {
        const int c8 = (item & 255) * 8, t0 = (item >> 8) * 32, ss = t0 & ~(SEQ - 1);
        float w0[8], w1[8], w2[8], m2[8], m1[8], m0[8], bz[8];
#pragma unroll
        for (int j = 0; j < 8; ++j) { w0[j] = cw[c8 + j]; w1[j] = cw[DI + c8 + j]; w2[j] = cw[2 * DI + c8 + j]; m2[j] = 0.f; m1[j] = 0.f; }
        if (t0 - 2 >= ss) unpack8(*(const u32x4*)(MB + (size_t)(t0 - 2) * DI + c8), m2);
        if (t0 - 1 >= ss) unpack8(*(const u32x4*)(MB + (size_t)(t0 - 1) * DI + c8), m1);
        for (int i = 0; i < 32; ++i) {
            const int t = t0 + i; unpack8(*(const u32x4*)(MB + (size_t)t * DI + c8), m0); unpack8(*(const u32x4*)(BZ + (size_t)t * DI + c8), bz);
            float o[8];
#pragma unroll
            for (int j = 0; j < 8; ++j) { o[j] = bz[j] * (w0[j] * m2[j] + w1[j] * m1[j] + w2[j] * m0[j]); m2[j] = m1[j]; m1[j] = m0[j]; }
            *(u32x4*)(BZ + (size_t)t * DI + c8) = pack8(o);
        }
    }
}
constexpr int A2_ST_OFF = 8 * 16384;
static_assert(A2_ST_OFF + 1024 <= LDS_BYTES, "A2 LDS");
__device__ __forceinline__ void a2_phase(LAS unsigned char* lds, bf16_t* PQ, const bf16_t* GV, const f32x2* stats, const float* vgain, const float* vbias, const bf16_t* Wb, const float* rsum, const float* b_s, int tid, int bid, int G) {
    const int lane = tid & 63, wid = __builtin_amdgcn_readfirstlane(tid >> 6), fr = lane & 15, fq = lane >> 4, g = wid;
    LAS unsigned char* VT = lds + wid * 16384;
    LAS float* MU = (LAS float*)(lds + A2_ST_OFF); LAS float* RS = MU + 128;
    for (int ch = bid; ch < MTOK / 128; ch += G) {
        const int t0 = ch * 128;
        __syncthreads();
        if (tid < 128) { const f32x4* sp = (const f32x4*)(stats + (size_t)(t0 + tid) * 32); float s = 0.f, s2 = 0.f;
#pragma unroll
            for (int i = 0; i < 16; ++i) { const f32x4 v = sp[i]; s += v.x + v.z; s2 += v.y + v.w; }
            const float mu = s * (1.f / DI), var = s2 * (1.f / DI) - mu * mu; MU[tid] = mu; RS[tid] = 1.0f / sqrtf(var + LN_EPS); }
        __syncthreads();
        const unsigned vo_gv = (unsigned)((lane >> 3) * DI + (lane & 7) * 8) * 2u, vo_w = (unsigned)(fr * 128 + 8 * fq) * 2u, vo_pq = (unsigned)(fr * DI + 4 * fq) * 2u, vo_c = (unsigned)fq * 16u, vo_t = (unsigned)fr * 4u;
        float bsv[8], rsv[8];
#pragma unroll
        for (int tb = 0; tb < 8; ++tb) { bsv[tb] = *(const float*)((const char*)(b_s + g * 128 + 16 * tb) + vo_t); rsv[tb] = *(const float*)((const char*)(rsum + g * 128 + 16 * tb) + vo_t); }
#pragma unroll 1
        for (int qt = 0; qt < 4; ++qt) {
            const int cbase = g * 256 + qt * 64;
            { u32x4 raw[16];
#pragma unroll
                for (int i = 0; i < 16; ++i) raw[i] = *(const u32x4*)((const char*)(GV + (size_t)(t0 + 8 * i) * DI + cbase) + vo_gv);
#pragma unroll
                for (int i = 0; i < 16; ++i) { const int s = 8 * i + (lane >> 3); float f[8]; unpack8(raw[i], f); const float mu = MU[s], rs = RS[s];
#pragma unroll
                    for (int j = 0; j < 8; ++j) f[j] = (f[j] - mu) * rs;
                    *(LAS u32x4*)(VT + s * 128 + (lane & 7) * 16) = pack8(f); } }
            asm volatile("s_waitcnt lgkmcnt(0)" ::: "memory");
#pragma unroll 1
            for (int pass = 0; pass < 2; ++pass) {
                f32x4 acc[2][8];
#pragma unroll
                for (int cb = 0; cb < 2; ++cb)
#pragma unroll
                    for (int tb = 0; tb < 8; ++tb) acc[cb][tb] = (f32x4){0.f, 0.f, 0.f, 0.f};
#pragma unroll 1
                for (int ks = 0; ks < 4; ++ks) {
                    bf16x8 af[2];
#pragma unroll
                    for (int cb = 0; cb < 2; ++cb) {
                        LAS unsigned char* p = VT + (32 * ks + 8 * fq + (fr >> 2)) * 128 + (32 * pass + 16 * cb + 4 * (fr & 3)) * 2;
                        const s16x4 lo = __builtin_amdgcn_ds_read_tr16_b64_v4i16((LAS s16x4*)p);
                        const s16x4 hi = __builtin_amdgcn_ds_read_tr16_b64_v4i16((LAS s16x4*)(p + 4 * 128));
                        af[cb] = (bf16x8){lo[0], lo[1], lo[2], lo[3], hi[0], hi[1], hi[2], hi[3]};
                    }
#pragma unroll
                    for (int tb = 0; tb < 8; ++tb) {
                        if (32 * ks <= 16 * tb + 15) {
                            const bf16x8 bf = *(const bf16x8*)((const char*)(Wb + ((size_t)g * 128 + 16 * tb) * 128 + 32 * ks) + vo_w);
#pragma unroll
                            for (int cb = 0; cb < 2; ++cb) acc[cb][tb] = __builtin_amdgcn_mfma_f32_16x16x32_bf16(af[cb], bf, acc[cb][tb], 0, 0, 0);
                        }
                    }
                }
#pragma unroll
                for (int cb = 0; cb < 2; ++cb) { const int cu = cbase + 32 * pass + 16 * cb; const f32x4 gn = *(const f32x4*)((const char*)(vgain + cu) + vo_c), bb = *(const f32x4*)((const char*)(vbias + cu) + vo_c);
#pragma unroll
                    for (int tb = 0; tb < 8; ++tb) { char* pp = (char*)(PQ + (size_t)(t0 + 16 * tb) * DI + cu) + vo_pq;
                        const u32x2 pv = *(const u32x2*)pp; const f32x4 sv = gn * acc[cb][tb] + bb * rsv[tb] + bsv[tb];
                        *(u32x2*)pp = (u32x2){cvt_pk_bf16(sv[0] * bf_lo(pv.x), sv[1] * bf_hi(pv.x)), cvt_pk_bf16(sv[2] * bf_lo(pv.y), sv[3] * bf_hi(pv.y))}; } }
            }
            asm volatile("s_waitcnt lgkmcnt(0)" ::: "memory");
        }
    }
}

__device__ __forceinline__ void transpose_item(const float* W, int Nsrc, int src_col0, bf16_t* WT, int K, int dst_row0, int k0, LAS float* scr, int lane) {
#pragma unroll 8
    for (int i = 0; i < 32; ++i) { const int kk = 2 * i + (lane >> 5); scr[kk * 33 + (lane & 31)] = W[(size_t)(k0 + kk) * Nsrc + src_col0 + (lane & 31)]; }
    asm volatile("s_waitcnt lgkmcnt(0)" ::: "memory");
    const int c = lane & 7;
#pragma unroll
    for (int j = 0; j < 4; ++j) { const int n = (lane >> 3) + 8 * j; const LAS float* s = scr + (8 * c) * 33 + n;
        u32x4 o; o.x = cvt_pk_bf16(s[0 * 33], s[1 * 33]); o.y = cvt_pk_bf16(s[2 * 33], s[3 * 33]); o.z = cvt_pk_bf16(s[4 * 33], s[5 * 33]); o.w = cvt_pk_bf16(s[6 * 33], s[7 * 33]);
        *(u32x4*)(WT + (size_t)(dst_row0 + n) * K + k0 + 8 * c) = o; }
    asm volatile("s_waitcnt lgkmcnt(0)" ::: "memory");
}
__device__ __forceinline__ int map_src_col(int kind, int n) {
    if (kind == 0) return n;
    const int rb = n >> 7, pn = rb >> 1, half = rb & 1, r = n & 127;
    if (kind == 1) return pn < 16 ? (half ? 4096 : 0) + 128 * pn + r : 2048 + (n - 4096);
    return pn < 16 ? (half ? 4096 : 2048) + 128 * pn + r : (half ? 6144 : 0) + 128 * (pn - 16) + r;
}
struct Args { const float* in[28]; float* out; unsigned char* ws; int ph_lo, ph_hi; };

#define KIN(i) (*(const float* const __attribute__((address_space(4)))*)(karg + 8 * (i)))
typedef const unsigned char __attribute__((address_space(4)))* karg_t;
__device__ __forceinline__ void prologue_phase(karg_t karg, unsigned char* ws, LAS unsigned char* lds, int tid, int bid, int G) {
    const int lane = tid & 63, wid = tid >> 6, gw = bid * 8 + wid, NGW = G * 8;
    LAS float* scr = (LAS float*)(lds + wid * 16384);
    for (int mi = 0; mi < 12; ++mi) {
        const float* W; bf16_t* WT; int K, Nsrc, Ndst, kind = 0;
        switch (mi) {
            case 0:  W = KIN(1);  WT = (bf16_t*)(ws + WS_WA0);           K = DM; Nsrc = 3 * DI; Ndst = 3 * DI; kind = 1; break;
            case 1:  W = KIN(6);  WT = (bf16_t*)(ws + WS_WA0 + W_A_OUT); K = DI; Nsrc = DM; Ndst = DM; break;
            case 2:  W = KIN(9);  WT = (bf16_t*)(ws + WS_WB);            K = DM; Nsrc = 2 * DI; Ndst = 2 * DI; break;
            case 3:  W = KIN(10);                 WT = (bf16_t*)(ws + WS_WB_GRP);                   K = 512; Nsrc = 512; Ndst = 512; break;
            case 4:  W = KIN(10) + 1 * 512 * 512; WT = (bf16_t*)(ws + WS_WB_GRP) + 1 * 512 * 512;   K = 512; Nsrc = 512; Ndst = 512; break;
            case 5:  W = KIN(10) + 2 * 512 * 512; WT = (bf16_t*)(ws + WS_WB_GRP) + 2 * 512 * 512;   K = 512; Nsrc = 512; Ndst = 512; break;
            case 6:  W = KIN(10) + 3 * 512 * 512; WT = (bf16_t*)(ws + WS_WB_GRP) + 3 * 512 * 512;   K = 512; Nsrc = 512; Ndst = 512; break;
            case 7:  W = KIN(12); WT = (bf16_t*)(ws + WS_WB_OUT);        K = DI; Nsrc = DM; Ndst = DM; break;
            case 8:  W = KIN(15); WT = (bf16_t*)(ws + WS_WC);            K = DM; Nsrc = 4 * DI; Ndst = 4 * DI; kind = 2; break;
            case 9:  W = KIN(17); WT = (bf16_t*)(ws + WS_WC_OUT);        K = DI; Nsrc = DM; Ndst = DM; break;
            case 10: W = KIN(20); WT = (bf16_t*)(ws + WS_WA3);           K = DM; Nsrc = 3 * DI; Ndst = 3 * DI; kind = 1; break;
            default: W = KIN(25); WT = (bf16_t*)(ws + WS_WA3 + W_A_OUT); K = DI; Nsrc = DM; Ndst = DM; break;
        }
        const int nblk = Ndst / 32, nitems = (K / 64) * nblk;
        for (int it = gw; it < nitems; it += NGW) { const int kb = it / nblk, nb = it % nblk; transpose_item(W, Nsrc, map_src_col(kind, nb * 32), WT, K, nb * 32, kb * 64, scr, lane); }
    }
    for (int sel = 0; sel < 2; ++sel) {
        const float* w_s = sel == 0 ? KIN(4) : KIN(23); bf16_t* Wb = (bf16_t*)(ws + WS_WSB + sel * 262144); float* rsum = (float*)(ws + WS_RSUM + sel * 4096);
        for (int r = gw; r < 1024; r += NGW) { const int t = r & 127; float a = w_s[(size_t)r * 128 + lane], b = w_s[(size_t)r * 128 + lane + 64];
            a = lane <= t ? a : 0.f; b = lane + 64 <= t ? b : 0.f;
            Wb[(size_t)r * 128 + lane] = (bf16_t)(cvt_pk_bf16(a, 0.f) & 0xffffu); Wb[(size_t)r * 128 + lane + 64] = (bf16_t)(cvt_pk_bf16(b, 0.f) & 0xffffu);
            const float s = wave_sum(a + b); if (lane == 0) rsum[r] = s; }
    }
    const float* x = KIN(0); bf16_t* XB = (bf16_t*)(ws + WS_XB);
    for (size_t i = (size_t)bid * 512 + tid; i < (size_t)MTOK * DM / 8; i += (size_t)G * 512) {
        const f32x4 v0 = *((const f32x4*)x + 2 * i), v1 = *((const f32x4*)x + 2 * i + 1);
        *((u32x4*)XB + i) = (u32x4){cvt_pk_bf16(v0.x, v0.y), cvt_pk_bf16(v0.z, v0.w), cvt_pk_bf16(v1.x, v1.y), cvt_pk_bf16(v1.z, v1.w)};
    }
}

constexpr int N_PHASES = 21;
__host__ __device__ inline bool phase_empty(int ph) { if (ph == 0) return false; const int li = (ph - 1) / 5, s = (ph - 1) % 5; return s == 2 && (li % 3) != 1; }

__global__ void __launch_bounds__(512, 2) mk_fwd(Args a_unused) {
    extern __shared__ __attribute__((aligned(16))) unsigned char lds_raw[];
    LAS unsigned char* lds = (LAS unsigned char*)lds_raw;
    int ph_lo, ph_hi; { karg_t k0 = (karg_t)__builtin_amdgcn_kernarg_segment_ptr(); ph_lo = *(const int __attribute__((address_space(4)))*)(k0 + 240); ph_hi = *(const int __attribute__((address_space(4)))*)(k0 + 244); }
    for (int ph = ph_lo, rep = 0; ph < ph_hi; ++ph) {
        if (phase_empty(ph)) continue;
        karg_t karg = (karg_t)__builtin_amdgcn_kernarg_segment_ptr(); asm volatile("" : "+s"(karg));
        int tid = threadIdx.x; asm volatile("" : "+v"(tid));
        int bid = blockIdx.x, G = gridDim.x; asm volatile("" : "+s"(bid), "+s"(G));
        float* out = *(float* const __attribute__((address_space(4)))*)(karg + 224);
        unsigned char* ws = *(unsigned char* const __attribute__((address_space(4)))*)(karg + 232);
        bf16_t* XB = (bf16_t*)(ws + WS_XB); bf16_t* BUFA = (bf16_t*)(ws + WS_BUFA); bf16_t* BUFB = (bf16_t*)(ws + WS_BUFB); bf16_t* BUFC = (bf16_t*)(ws + WS_BUFC);
        float* Y = (float*)(ws + WS_BUFA);
        f32x2* stats = (f32x2*)(ws + WS_STATS);
        __syncthreads();
        if (ph == 0) prologue_phase(karg, ws, lds, tid, bid, G);
        else {
            const int li = (ph - 1) / 5, slot = (ph - 1) % 5, kind = li % 3;
            const bf16_t* Win = (const bf16_t*)(ws + (li == 0 ? WS_WA0 : li == 1 ? WS_WB : li == 2 ? WS_WC : WS_WA3));
            const bf16_t* Wout = (const bf16_t*)(ws + (li == 0 ? WS_WA0 + W_A_OUT : li == 1 ? WS_WB_OUT : li == 2 ? WS_WC_OUT : WS_WA3 + W_A_OUT));
            if (slot == 0) {
                if (kind == 0) { Gemm g{XB, Win, DM, DM, DM}; StaticOrder<false> S; S.init(MTOK, 3 * DI, G, bid); EpiA1 E{BUFB, BUFA, stats}; gemm_phase(lds, g, S, E, tid); }
                else if (kind == 1) { Gemm g{XB, Win, DM, DM, DM}; StaticOrder<false> S; S.init(MTOK, 2 * DI, G, bid); EpiB1 E{BUFA, BUFB, KIN(11)}; gemm_phase(lds, g, S, E, tid); }
                else { Gemm g{XB, Win, DM, DM, DM}; StaticOrder<false> S; S.init(MTOK, 4 * DI, G, bid); EpiC1 E{BUFA, BUFB}; gemm_phase(lds, g, S, E, tid); }
            } else if (slot == 1) {
                const int b = li == 0 ? 0 : 19;
                if (kind == 0) a2_phase(lds, BUFB, BUFA, stats, KIN(2 + b), KIN(3 + b), (const bf16_t*)(ws + WS_WSB + (li == 0 ? 0 : 262144)), (const float*)(ws + WS_RSUM + (li == 0 ? 0 : 4096)), KIN(5 + b), tid, bid, G);
                else if (kind == 1) pool_phase(BUFA, BUFC, tid, bid, G);
                else conv_phase(BUFA, BUFB, KIN(16), tid, bid, G);
            } else if (slot == 2) {
                Gemm g{BUFC, (const bf16_t*)(ws + WS_WB_GRP), DI, 512, 512}; StaticOrder<true> S; S.init(MTOK, DI, G, bid); EpiBgrp E{BUFB}; gemm_phase(lds, g, S, E, tid);
            } else if (slot == 3) {
                Gemm g{BUFB, Wout, DI, DI, DI}; StaticOrder<false> S; S.init(MTOK, DM, G, bid); EpiG2 E{li == 0 ? KIN(0) : (const float*)out, Y}; gemm_phase(lds, g, S, E, tid);
            } else {
                const int gi = li == 0 ? 7 : li == 1 ? 13 : li == 2 ? 18 : 26;
                ln_phase(Y, KIN(gi), KIN(gi + 1), out, XB, li != 3, tid, bid, G);
            }
        }
#ifdef DUP_MASK
        { const int dslot = ph == 0 ? 5 : (ph - 1) % 5; const bool dup = ((DUP_MASK >> dslot) & 1) && !(dslot == 1 && ((ph - 1) / 5) % 3 != 1);
          if (dup && rep == 0) { rep = 1; --ph; continue; } rep = 0; }
#endif
        if (ph + 1 < ph_hi) cg::this_grid().sync();
    }
}

extern "C" void kernel_launch(void* const* d_in, const int* in_sizes, int n_in, void* d_out, int out_size, void* d_ws, size_t ws_size, hipStream_t stream) {
    static int grid = 0;
    if (grid == 0) {
        if (n_in != 28 || in_sizes[0] != MTOK * DM || out_size != MTOK * DM || ws_size < WS_END) { fprintf(stderr, "kernel_launch: unexpected shapes: n_in %d in0 %d out %d ws %zu (need %zu)\n", n_in, n_in > 0 ? in_sizes[0] : -1, out_size, ws_size, (size_t)WS_END); grid = -1; return; }
        int dev = 0, cus = 0, per_cu = 0;
        if (hipGetDevice(&dev) != hipSuccess || hipDeviceGetAttribute(&cus, hipDeviceAttributeMultiprocessorCount, dev) != hipSuccess) { fprintf(stderr, "kernel_launch: device query failed\n"); grid = -1; return; }
        if (hipFuncSetAttribute((const void*)mk_fwd, hipFuncAttributeMaxDynamicSharedMemorySize, LDS_BYTES) != hipSuccess) { fprintf(stderr, "kernel_launch: hipFuncSetAttribute failed\n"); grid = -1; return; }
        if (hipOccupancyMaxActiveBlocksPerMultiprocessor(&per_cu, (const void*)mk_fwd, 512, LDS_BYTES) != hipSuccess || per_cu < 1) { fprintf(stderr, "kernel_launch: occupancy query says %d blocks/CU\n", per_cu); per_cu = 1; }
        (void)hipGetLastError();
        grid = cus * per_cu;
        fprintf(stderr, "kernel_launch: grid %d (cus %d x %d)\n", grid, cus, per_cu);
    }
    if (grid < 0) return;
    Args a{};
    for (int i = 0; i < 28; ++i) a.in[i] = (const float*)d_in[i];
    a.out = (float*)d_out; a.ws = (unsigned char*)d_ws;
#if MK_MULTI
    for (int ph = 0; ph < N_PHASES; ++ph) {
        if (phase_empty(ph)) continue;
        a.ph_lo = ph; a.ph_hi = ph + 1;
        hipLaunchKernelGGL(mk_fwd, dim3(grid), dim3(512), LDS_BYTES, stream, a);
    }
#else
    a.ph_lo = 0; a.ph_hi = N_PHASES;
    void* args[] = {&a};
    hipError_t e = hipLaunchCooperativeKernel((const void*)mk_fwd, dim3(grid), dim3(512), args, LDS_BYTES, stream);
    if (e != hipSuccess) fprintf(stderr, "kernel_launch: cooperative launch failed: %s (grid %d)\n", hipGetErrorString(e), grid);
#endif
}
```

```cpp
#include <hip/hip_runtime.h>
#include <hip/hip_cooperative_groups.h>
#include <cstdio>
namespace cg = cooperative_groups;

#ifndef MK_MULTI
#define MK_MULTI 0
#endif

#define LAS __attribute__((address_space(3)))
typedef unsigned short bf16_t;
typedef short bf16x8 __attribute__((ext_vector_type(8)));
typedef short s16x4 __attribute__((ext_vector_type(4)));
typedef float f32x4 __attribute__((ext_vector_type(4)));
typedef float f32x2 __attribute__((ext_vector_type(2)));
typedef unsigned u32x4 __attribute__((ext_vector_type(4)));
typedef unsigned u32x2 __attribute__((ext_vector_type(2)));

constexpr int DM = 1024, DI = 2048, SEQ = 8192, MTOK = 4 * SEQ;
constexpr float LN_EPS = 1e-5f;
constexpr float ALPHA = 1.6817928305074292f;

constexpr int BM = 256, BK = 64, HALF = 128, HTB = HALF * BK * 2  , STAGE_BYTES = 8 * HTB, NXCD = 8, WGM = 8;
constexpr int LDS_BAR_OFF = 147456 - 64;
constexpr int LDS_BYTES = 147456;

constexpr size_t MiB = 1u << 20;
constexpr size_t WS_BAR = 0, WS_BAR_BYTES = 16384;
constexpr size_t WS_STATS = 1 * MiB;
constexpr size_t WS_WSB = 9 * MiB, WS_RSUM = 10 * MiB;
constexpr size_t WS_W = 16 * MiB;
constexpr size_t W_A_IN = 0, W_A_OUT = 12 * MiB, W_A_SZ = 16 * MiB;
constexpr size_t WS_WA0 = WS_W, WS_WB = WS_WA0 + W_A_SZ, WS_WB_GRP = WS_WB + 8 * MiB, WS_WB_OUT = WS_WB + 10 * MiB, WS_WC = WS_WB + 14 * MiB, WS_WC_OUT = WS_WC + 16 * MiB, WS_WA3 = WS_WC + 20 * MiB;
constexpr size_t WS_XB = WS_WA3 + W_A_SZ;
constexpr size_t WS_BUFC = WS_XB;
constexpr size_t WS_BUFA = WS_XB + 128 * MiB;
constexpr size_t WS_BUFB = WS_BUFA + 128 * MiB;
constexpr size_t WS_END = WS_BUFB + 128 * MiB;
static_assert(WS_XB == 82 * MiB, "ws map");

__device__ __forceinline__ unsigned cvt_pk_bf16(float lo, float hi) { unsigned r; asm volatile("v_cvt_pk_bf16_f32 %0, %1, %2" : "=v"(r) : "v"(lo), "v"(hi)); return r; }
__device__ __forceinline__ float bf_lo(unsigned w) { return __uint_as_float(w << 16); }
__device__ __forceinline__ float bf_hi(unsigned w) { return __uint_as_float(w & 0xffff0000u); }
__device__ __forceinline__ float sigmoid_f(float x) { return __builtin_amdgcn_rcpf(1.0f + __builtin_amdgcn_exp2f(-1.4426950408889634f * x)); }
__device__ __forceinline__ float silu_f(float x) { return x * sigmoid_f(x); }
__device__ __forceinline__ float gelu_f(float x) { return x * sigmoid_f(1.5957691216057308f * x * (1.0f + 0.044715f * x * x)); }

__host__ __device__ __forceinline__ int lds_byte(int r, int c) { const int st = (r >> 4) * 2 + (c >> 5), rr = r & 15, cc = c & 31, ob = rr * 64 + cc * 2; return st * 1024 + (ob ^ (((ob >> 9) & 1) << 5)); }
__host__ __device__ __forceinline__ void stage_rc(int b, int& R, int& C) { const int st = b / 1024, sb = b % 1024, swz = sb ^ (((sb >> 9) & 1) << 5); R = (st >> 1) * 16 + swz / 64; C = (st & 1) * 32 + (swz % 64) / 2; }
__host__ __device__ __forceinline__ int perm32(int rho) { const int n = rho >> 4, i = rho & 15; return 8 * (i >> 2) + 4 * n + (i & 3); }

struct Unit { int pm, pn, aoff; };
struct Gemm { const bf16_t* A; const bf16_t* Bt; int lda, ldb, K; };

template <bool GRP> struct StaticOrder {
    int nM, nN, nwg, G, c;
    __device__ void init(int M, int N, int G_, int c_) { nM = M / BM; nN = N / BM; nwg = nM * nN; G = G_; c = c_; }
    __device__ bool next(int i, Unit& u) const {
        const long L = (long)i * G + c; if (L >= nwg) return false;
        int wgid = (int)L; { const int q = nwg / NXCD, r = nwg % NXCD, xcd = wgid % NXCD, off = wgid / NXCD; wgid = (xcd < r ? xcd * (q + 1) : r * (q + 1) + (xcd - r) * q) + off; }
        const int nig = WGM * nN, gid = wgid / nig, fm = gid * WGM, gsz = (nM - fm) < WGM ? (nM - fm) : WGM;
        u.pm = fm + ((wgid % nig) % gsz); u.pn = (wgid % nig) / gsz; u.aoff = GRP ? (u.pn >> 1) * 1024 : 0; return true;
    }
    __device__ __forceinline__ void a_ready(const Unit&) const {}
    __device__ __forceinline__ void done(const Unit&) const {}
};

#define XB_TMO      128
#define XB_XCNT(j)  (256  + 64 * (j))
#define XB_XSUB(j)  (1280 + 64 * (j))
#define XB_XGEN(j)  (2304 + 64 * (j))
#define XB_TOP      3328
#define XB_TOPGEN   3392
#define XCD_BAR_WORDS 3456
#define XB_SPIN_CAP (1u << 18)

__device__ __forceinline__ unsigned xb_ld(unsigned* p)              { return __hip_atomic_load(p, __ATOMIC_RELAXED, __HIP_MEMORY_SCOPE_AGENT); }
__device__ __forceinline__ unsigned xb_add(unsigned* p, unsigned v) { return __hip_atomic_fetch_add(p, v, __ATOMIC_RELAXED, __HIP_MEMORY_SCOPE_AGENT); }
__device__ __forceinline__ unsigned xb_xcc_id() { return (unsigned)__builtin_amdgcn_s_getreg((3 << 11) | 20) & 0xFu; }
#define XB_SPIN(cond, bar) do { unsigned _sp = 0; while (cond) { __builtin_amdgcn_s_sleep(1); \
    if ((++_sp & 255u) == 0u) { if (xb_ld(&(bar)[XB_TMO])) break; if (_sp > XB_SPIN_CAP) { atomicAdd(&(bar)[XB_TMO], 1u); break; } } } } while (0)

struct XcdBarrier {
    unsigned* bar; unsigned x;
    volatile LAS unsigned* st;
};

__device__ __forceinline__ XcdBarrier xcd_barrier_post(unsigned* bar, volatile LAS unsigned* st) {
    XcdBarrier b; b.bar = bar; b.x = xb_xcc_id(); b.st = st;
    if (threadIdx.x == 0) (void)xb_add(&bar[XB_XCNT(b.x)], 1u);
    return b;
}
__device__ __forceinline__ void xcd_barrier_complete(unsigned* bar, unsigned x, unsigned& nloc, unsigned& nx) {
    const unsigned G = gridDim.x * gridDim.y * gridDim.z;
    unsigned sum, cnt, mine, sp = 0u;
    for (;;) {
        sum = 0u; cnt = 0u; mine = 0u;
#pragma unroll
        for (unsigned j = 0; j < 16; ++j) { const unsigned c = xb_ld(&bar[XB_XCNT(j)]); sum += c; cnt += (c > 0u) ? 1u : 0u; mine = (j == x) ? c : mine; }
        if (sum == G) break;
        __builtin_amdgcn_s_sleep(1);
        if ((++sp & 255u) == 0u) { if (xb_ld(&bar[XB_TMO])) break; if (sp > XB_SPIN_CAP) { atomicAdd(&bar[XB_TMO], 1u); break; } }
    }
    nloc = mine > 0u ? mine : 1u; nx = cnt > 0u ? cnt : 1u;
}

__device__ __forceinline__ void xcd_barrier(const XcdBarrier& b) {
    asm volatile("s_waitcnt vmcnt(0)" ::: "memory");
    __syncthreads();
    if (threadIdx.x == 0) {
        unsigned* bar = b.bar;
        __builtin_amdgcn_s_waitcnt(0);
        unsigned nloc = b.st[0], nx = b.st[1];
        if (nloc == 0u) { xcd_barrier_complete(bar, b.x, nloc, nx); b.st[0] = nloc; b.st[1] = nx; }
        const unsigned old = xb_add(&bar[XB_XSUB(b.x)], 1u);
        const unsigned gen = old / nloc;
        if (old + 1u == (gen + 1u) * nloc) {
            __builtin_amdgcn_fence(__ATOMIC_RELEASE, "agent");
            asm volatile("s_waitcnt vmcnt(0)" ::: "memory");
            const unsigned og = xb_add(&bar[XB_TOP], 1u);
            const unsigned tg = og / nx;
            if (og + 1u == (tg + 1u) * nx) xb_add(&bar[XB_TOPGEN], 1u);
            else XB_SPIN(xb_ld(&bar[XB_TOPGEN]) == tg, bar);
            __builtin_amdgcn_fence(__ATOMIC_ACQUIRE, "agent");
            xb_add(&bar[XB_XGEN(b.x)], 1u);
            asm volatile("s_waitcnt vmcnt(0)" ::: "memory");
        } else {
            XB_SPIN(xb_ld(&bar[XB_XGEN(b.x)]) == gen, bar);
            __builtin_amdgcn_fence(__ATOMIC_ACQUIRE, "agent");
            asm volatile("s_waitcnt vmcnt(0)" ::: "memory");
        }
    }
    __syncthreads();
}


template <class Epi, class Sched>
__device__ __forceinline__ void gemm_phase(LAS unsigned char* lds, const Gemm g, const Sched& S, const Epi& E, const int tid_in) {
    const int tid = tid_in, wid = __builtin_amdgcn_readfirstlane(tid >> 6), lane = tid & 63, wr = wid >> 2, wc = wid & 3, fr = lane & 15, fq = lane >> 4;
    const int K = g.K, nt = K / BK;
#define PG8_STAMP() do {} while (0)
    PG8_STAMP();
    unsigned voffA[2], voffB[2];
#pragma unroll
    for (int i = 0; i < 2; ++i) { int R, C; stage_rc(tid * 16 + i * 8192, R, C); const int Rb = Epi::PERM ? ((R & ~31) + perm32(R & 31)) : R;
        voffA[i] = (unsigned)(R * g.lda + C) * 2u; voffB[i] = (unsigned)(Rb * g.ldb + C) * 2u; }
    const size_t kstep = (size_t)(BK * 2);
    const size_t hstepA = (size_t)HALF * g.lda * 2, hstepB = (size_t)HALF * g.ldb * 2;
    const size_t tstepA = 2 * hstepA, tstepB = 2 * hstepB;
    const unsigned ldsw = (unsigned)wid * 1024u;
    const int aoff = lds_byte(wr * 64 + fr, fq * 8), boff = lds_byte(wc * 32 + fr, fq * 8);
#define PG8_SA(b, h) (((b) * 2 + (h)) * HTB)
#define PG8_SB(b, h) ((4 + (b) * 2 + (h)) * HTB)
#define PG8_STAGE(bufoff, gbase, voff) do { _Pragma("unroll") for (int _i = 0; _i < 2; ++_i) \
        __builtin_amdgcn_global_load_lds((const unsigned*)((const char*)(gbase) + (voff)[_i]), (LAS unsigned*)(lds + (bufoff) + ldsw + _i * 8192), 16, 0, 0); } while (0)
#define PG8_LDA(dst, b, h) do { _Pragma("unroll") for (int m = 0; m < 4; ++m) _Pragma("unroll") for (int k = 0; k < 2; ++k) dst[m][k] = *(const LAS bf16x8*)(lds + PG8_SA(b, h) + aoff + m * 2048 + k * 1024); } while (0)
#define PG8_LDB(dst, b, h) do { _Pragma("unroll") for (int n = 0; n < 2; ++n) _Pragma("unroll") for (int k = 0; k < 2; ++k) dst[n][k] = *(const LAS bf16x8*)(lds + PG8_SB(b, h) + boff + n * 2048 + k * 1024); } while (0)
#define PG8_MMA(ai, bj, At, Bt) do { __builtin_amdgcn_s_setprio(1); _Pragma("unroll") for (int m = 0; m < 4; ++m) _Pragma("unroll") for (int n = 0; n < 2; ++n) _Pragma("unroll") for (int k = 0; k < 2; ++k) \
        acc[ai][bj][m][n] = __builtin_amdgcn_mfma_f32_16x16x32_bf16(Bt[n][k], At[m][k], acc[ai][bj][m][n], 0, 0, 0); __builtin_amdgcn_s_setprio(0); } while (0)
#define PG8_WAIT_V(n) asm volatile("s_waitcnt vmcnt(" #n ")" ::: "memory")
#define PG8_WAIT_L(n) asm volatile("s_waitcnt lgkmcnt(" #n ")" ::: "memory")
#define PG8_BAR __builtin_amdgcn_s_barrier()
#define PG8_SCHED __builtin_amdgcn_sched_barrier(0)
    Unit cur, nxt; int ui = 0;
    if (!S.next(0, cur)) return;
    f32x4 acc[2][2][4][2];
#pragma unroll
    for (int a = 0; a < 2; ++a)
#pragma unroll
        for (int b = 0; b < 2; ++b)
#pragma unroll
            for (int m = 0; m < 4; ++m)
#pragma unroll
                for (int n = 0; n < 2; ++n) acc[a][b][m][n] = (f32x4){0.f, 0.f, 0.f, 0.f};
    bf16x8 At[4][2], B0[2][2], B1[2][2];
    const char* cA = (const char*)g.A + cur.aoff + (size_t)cur.pm * tstepA; const char* cB = (const char*)g.Bt + (size_t)cur.pn * tstepB;
    S.a_ready(cur);
    PG8_STAGE(PG8_SB(0, 0), cB, voffB); PG8_STAGE(PG8_SA(0, 0), cA, voffA); PG8_STAGE(PG8_SB(0, 1), cB + hstepB, voffB); PG8_STAGE(PG8_SA(0, 1), cA + hstepA, voffA);
    if (wr == 1) PG8_BAR;
    PG8_WAIT_V(4); PG8_BAR;
    PG8_STAGE(PG8_SB(1, 0), cB + kstep, voffB); PG8_STAGE(PG8_SA(1, 0), cA + kstep, voffA); PG8_STAGE(PG8_SB(1, 1), cB + hstepB + kstep, voffB);
    PG8_WAIT_V(6); PG8_BAR;
    PG8_STAMP();
    for (;;) {
        const bool has_next = S.next(ui + 1, nxt);
        const char* nA = has_next ? (const char*)g.A + nxt.aoff + (size_t)nxt.pm * tstepA : cA; const char* nB = has_next ? (const char*)g.Bt + (size_t)nxt.pn * tstepB : cB;
        for (int t = 0; t < nt; t += 2) {
            const bool last = (t == nt - 2);
            const char* a1 = cA + (size_t)(t + 1) * kstep;
            const char* a2 = last ? nA : cA + (size_t)(t + 2) * kstep; const char* b2 = last ? nB : cB + (size_t)(t + 2) * kstep;
            const char* a3 = a2 + kstep; const char* b3 = b2 + kstep;
            if (last && has_next) S.a_ready(nxt);
            PG8_LDB(B0, 0, 0); PG8_SCHED; PG8_LDA(At, 0, 0); PG8_STAGE(PG8_SA(1, 1), a1 + hstepA, voffA);
            PG8_WAIT_L(8); PG8_BAR; PG8_WAIT_L(0); PG8_MMA(0, 0, At, B0); PG8_BAR; PG8_SCHED;
            PG8_LDB(B1, 0, 1); PG8_STAGE(PG8_SB(0, 0), b2, voffB);
            PG8_BAR; PG8_WAIT_L(0); PG8_MMA(0, 1, At, B1); PG8_BAR;
            PG8_LDA(At, 0, 1); PG8_STAGE(PG8_SA(0, 0), a2, voffA);
            PG8_BAR; PG8_WAIT_L(0); PG8_MMA(1, 0, At, B0); PG8_BAR; PG8_SCHED;
            PG8_STAGE(PG8_SB(0, 1), b2 + hstepB, voffB);
            PG8_WAIT_V(6); PG8_BAR; PG8_MMA(1, 1, At, B1); PG8_BAR;
            PG8_LDB(B0, 1, 0); PG8_SCHED; PG8_LDA(At, 1, 0); PG8_STAGE(PG8_SA(0, 1), a2 + hstepA, voffA);
            PG8_WAIT_L(8); PG8_BAR; PG8_WAIT_L(0); PG8_MMA(0, 0, At, B0); PG8_BAR; PG8_SCHED;
            PG8_LDB(B1, 1, 1); PG8_STAGE(PG8_SB(1, 0), b3, voffB);
            PG8_BAR; PG8_WAIT_L(0); PG8_MMA(0, 1, At, B1); PG8_BAR;
            PG8_LDA(At, 1, 1); PG8_STAGE(PG8_SA(1, 0), a3, voffA);
            PG8_BAR; PG8_WAIT_L(0); PG8_MMA(1, 0, At, B0); PG8_BAR; PG8_SCHED;
            PG8_STAGE(PG8_SB(1, 1), b3 + hstepB, voffB);
            PG8_WAIT_V(6); PG8_BAR; PG8_MMA(1, 1, At, B1); PG8_BAR;
        }
        PG8_STAMP();
        if constexpr (!Epi::AFTER_DRAIN) { E(acc, cur, wr, wc, fr, fq); S.done(cur); }
        PG8_STAMP();
        if (!has_next) break;
#pragma unroll
        for (int a = 0; a < 2; ++a)
#pragma unroll
            for (int b = 0; b < 2; ++b)
#pragma unroll
                for (int m = 0; m < 4; ++m)
#pragma unroll
                    for (int n = 0; n < 2; ++n) acc[a][b][m][n] = (f32x4){0.f, 0.f, 0.f, 0.f};
        cur = nxt; cA = nA; cB = nB; ++ui;
    }
    PG8_WAIT_V(0);
    if (wr == 0) PG8_BAR;
    PG8_BAR;
    if constexpr (Epi::AFTER_DRAIN) { E.fused(acc, cur, wr, wc, fr, fq, lds, wid, lane); S.done(cur); }
    PG8_STAMP();
#undef PG8_STAMP
#undef PG8_SA
#undef PG8_SB
#undef PG8_STAGE
#undef PG8_LDA
#undef PG8_LDB
#undef PG8_MMA
#undef PG8_WAIT_V
#undef PG8_WAIT_L
#undef PG8_BAR
#undef PG8_SCHED
}

struct EpiA1 {
    static constexpr bool PERM = true, AFTER_DRAIN = false;
    bf16_t* P; bf16_t* GV; f32x2* stats;
    __device__ __forceinline__ void operator()(const f32x4 (&acc)[2][2][4][2], const Unit& u, int wr, int wc, int fr, int fq) const {
        const int row0 = u.pm * BM + wr * 64 + fr;
        if (u.pn < 16) {
            const int col0 = u.pn * 128 + wc * 32 + 8 * fq;
#pragma unroll
            for (int ai = 0; ai < 2; ++ai)
#pragma unroll
                for (int m = 0; m < 4; ++m) {
                    const f32x4 u0 = acc[ai][0][m][0], u1 = acc[ai][0][m][1], z0 = acc[ai][1][m][0], z1 = acc[ai][1][m][1];
                    u32x4 w;
                    w.x = cvt_pk_bf16(gelu_f(u0[0]) * silu_f(z0[0]), gelu_f(u0[1]) * silu_f(z0[1]));
                    w.y = cvt_pk_bf16(gelu_f(u0[2]) * silu_f(z0[2]), gelu_f(u0[3]) * silu_f(z0[3]));
                    w.z = cvt_pk_bf16(gelu_f(u1[0]) * silu_f(z1[0]), gelu_f(u1[1]) * silu_f(z1[1]));
                    w.w = cvt_pk_bf16(gelu_f(u1[2]) * silu_f(z1[2]), gelu_f(u1[3]) * silu_f(z1[3]));
                    *(u32x4*)(P + (size_t)(row0 + ai * HALF + m * 16) * DI + col0) = w;
                }
        } else {
            const int pv = u.pn - 16, col0 = pv * 256 + wc * 32 + 8 * fq;
#pragma unroll
            for (int ai = 0; ai < 2; ++ai)
#pragma unroll
                for (int m = 0; m < 4; ++m) {
                    const int row = row0 + ai * HALF + m * 16; float s = 0.f, s2 = 0.f;
#pragma unroll
                    for (int bj = 0; bj < 2; ++bj) {
                        const f32x4 v0 = acc[ai][bj][m][0], v1 = acc[ai][bj][m][1];
                        u32x4 w;
                        w.x = cvt_pk_bf16(gelu_f(v0[0]), gelu_f(v0[1])); w.y = cvt_pk_bf16(gelu_f(v0[2]), gelu_f(v0[3]));
                        w.z = cvt_pk_bf16(gelu_f(v1[0]), gelu_f(v1[1])); w.w = cvt_pk_bf16(gelu_f(v1[2]), gelu_f(v1[3]));
                        *(u32x4*)(GV + (size_t)row * DI + col0 + bj * HALF) = w;
#pragma unroll
                        for (int j = 0; j < 4; ++j) { const float a = bf_lo(w[j]), b = bf_hi(w[j]); s += a + b; s2 += a * a + b * b; }
                    }
                    s += __shfl_xor(s, 16); s += __shfl_xor(s, 32); s2 += __shfl_xor(s2, 16); s2 += __shfl_xor(s2, 32);
                    if (fq == 0) stats[(size_t)row * 32 + pv * 4 + wc] = (f32x2){s, s2};
                }
        }
    }
};
struct EpiB1 {
    static constexpr bool PERM = true, AFTER_DRAIN = false;
    bf16_t* V; bf16_t* SZ; const float* scale;
    __device__ __forceinline__ void operator()(const f32x4 (&acc)[2][2][4][2], const Unit& u, int wr, int wc, int fr, int fq) const {
        const int row0 = u.pm * BM + wr * 64 + fr;
        if (u.pn < 8) {
            const int col0 = u.pn * 256 + wc * 32 + 8 * fq;
#pragma unroll
            for (int ai = 0; ai < 2; ++ai)
#pragma unroll
                for (int m = 0; m < 4; ++m)
#pragma unroll
                    for (int bj = 0; bj < 2; ++bj) {
                        const f32x4 v0 = acc[ai][bj][m][0], v1 = acc[ai][bj][m][1]; u32x4 w;
                        w.x = cvt_pk_bf16(v0[0], v0[1]); w.y = cvt_pk_bf16(v0[2], v0[3]); w.z = cvt_pk_bf16(v1[0], v1[1]); w.w = cvt_pk_bf16(v1[2], v1[3]);
                        *(u32x4*)(V + (size_t)(row0 + ai * HALF + m * 16) * DI + col0 + bj * HALF) = w;
                    }
        } else {
            const int col0 = (u.pn - 8) * 256 + wc * 32 + 8 * fq;
            f32x4 sc[2][2];
#pragma unroll
            for (int bj = 0; bj < 2; ++bj) { sc[bj][0] = *(const f32x4*)(scale + col0 + bj * HALF); sc[bj][1] = *(const f32x4*)(scale + col0 + bj * HALF + 4); }
#pragma unroll
            for (int ai = 0; ai < 2; ++ai)
#pragma unroll
                for (int m = 0; m < 4; ++m)
#pragma unroll
                    for (int bj = 0; bj < 2; ++bj) {
                        const f32x4 z0 = acc[ai][bj][m][0], z1 = acc[ai][bj][m][1]; u32x4 w;
                        w.x = cvt_pk_bf16(silu_f(z0[0]) * sc[bj][0][0], silu_f(z0[1]) * sc[bj][0][1]); w.y = cvt_pk_bf16(silu_f(z0[2]) * sc[bj][0][2], silu_f(z0[3]) * sc[bj][0][3]);
                        w.z = cvt_pk_bf16(silu_f(z1[0]) * sc[bj][1][0], silu_f(z1[1]) * sc[bj][1][1]); w.w = cvt_pk_bf16(silu_f(z1[2]) * sc[bj][1][2], silu_f(z1[3]) * sc[bj][1][3]);
                        *(u32x4*)(SZ + (size_t)(row0 + ai * HALF + m * 16) * DI + col0 + bj * HALF) = w;
                    }
        }
    }
};
struct EpiBgrp {
    static constexpr bool PERM = true, AFTER_DRAIN = false;
    const bf16_t* SZ; bf16_t* R;
    __device__ __forceinline__ void operator()(const f32x4 (&acc)[2][2][4][2], const Unit& u, int wr, int wc, int fr, int fq) const {
        const int row0 = u.pm * BM + wr * 64 + fr, col0 = u.pn * 256 + wc * 32 + 8 * fq;
#pragma unroll
        for (int ai = 0; ai < 2; ++ai)
#pragma unroll
            for (int m = 0; m < 4; ++m)
#pragma unroll
                for (int bj = 0; bj < 2; ++bj) {
                    const size_t eo = (size_t)(row0 + ai * HALF + m * 16) * DI + col0 + bj * HALF; bf16_t* p = R + eo;
                    const u32x4 s = *(const u32x4*)(SZ + eo); const f32x4 v0 = acc[ai][bj][m][0], v1 = acc[ai][bj][m][1]; u32x4 w;
                    w.x = cvt_pk_bf16(v0[0] * bf_lo(s.x), v0[1] * bf_hi(s.x)); w.y = cvt_pk_bf16(v0[2] * bf_lo(s.y), v0[3] * bf_hi(s.y));
                    w.z = cvt_pk_bf16(v1[0] * bf_lo(s.z), v1[1] * bf_hi(s.z)); w.w = cvt_pk_bf16(v1[2] * bf_lo(s.w), v1[3] * bf_hi(s.w));
                    *(u32x4*)p = w;
                }
    }
};
struct EpiC1 {
    static constexpr bool PERM = true, AFTER_DRAIN = false;
    bf16_t* MB; bf16_t* BZ;
    __device__ __forceinline__ void operator()(const f32x4 (&acc)[2][2][4][2], const Unit& u, int wr, int wc, int fr, int fq) const {
        const int row0 = u.pm * BM + wr * 64 + fr;
        if (u.pn < 16) {
            const int col0 = u.pn * 128 + wc * 32 + 8 * fq;
#pragma unroll
            for (int ai = 0; ai < 2; ++ai)
#pragma unroll
                for (int m = 0; m < 4; ++m) {
                    const f32x4 a0 = acc[ai][0][m][0], a1 = acc[ai][0][m][1], b0 = acc[ai][1][m][0], b1 = acc[ai][1][m][1]; u32x4 w;
                    w.x = cvt_pk_bf16(a0[0] * b0[0], a0[1] * b0[1]); w.y = cvt_pk_bf16(a0[2] * b0[2], a0[3] * b0[3]);
                    w.z = cvt_pk_bf16(a1[0] * b1[0], a1[1] * b1[1]); w.w = cvt_pk_bf16(a1[2] * b1[2], a1[3] * b1[3]);
                    *(u32x4*)(MB + (size_t)(row0 + ai * HALF + m * 16) * DI + col0) = w;
                }
        } else {
            const int col0 = (u.pn - 16) * 128 + wc * 32 + 8 * fq;
#pragma unroll
            for (int ai = 0; ai < 2; ++ai)
#pragma unroll
                for (int m = 0; m < 4; ++m) {
                    const f32x4 a0 = acc[ai][0][m][0], a1 = acc[ai][0][m][1], z0 = acc[ai][1][m][0], z1 = acc[ai][1][m][1]; u32x4 w;
                    w.x = cvt_pk_bf16(a0[0] * silu_f(z0[0]), a0[1] * silu_f(z0[1])); w.y = cvt_pk_bf16(a0[2] * silu_f(z0[2]), a0[3] * silu_f(z0[3]));
                    w.z = cvt_pk_bf16(a1[0] * silu_f(z1[0]), a1[1] * silu_f(z1[1])); w.w = cvt_pk_bf16(a1[2] * silu_f(z1[2]), a1[3] * silu_f(z1[3]));
                    *(u32x4*)(BZ + (size_t)(row0 + ai * HALF + m * 16) * DI + col0) = w;
                }
        }
    }
};
struct EpiG2 {
    static constexpr bool PERM = false, AFTER_DRAIN = false;
    const float* X; float* Y;
    __device__ __forceinline__ void operator()(const f32x4 (&acc)[2][2][4][2], const Unit& u, int wr, int wc, int fr, int fq) const {
        const int row0 = u.pm * BM + wr * 64 + fr, col0 = u.pn * BM + wc * 32 + 4 * fq;
#pragma unroll
        for (int ai = 0; ai < 2; ++ai)
#pragma unroll
            for (int m = 0; m < 4; ++m) { const size_t off = (size_t)(row0 + ai * HALF + m * 16) * DM + col0;
#pragma unroll
                for (int bj = 0; bj < 2; ++bj)
#pragma unroll
                    for (int n = 0; n < 2; ++n) { const f32x4 xv = *(const f32x4*)(X + off + bj * HALF + n * 16); *(f32x4*)(Y + off + bj * HALF + n * 16) = acc[ai][bj][m][n] + ALPHA * xv; }
                asm volatile("" ::: "memory"); }
    }
};

__device__ __forceinline__ float wave_sum(float v) {
#pragma unroll
    for (int o = 1; o < 64; o <<= 1) v += __shfl_xor(v, o);
    return v;
}
__device__ __forceinline__ void ln_phase(const float* Y, const float* gain, const float* bias, float* X, bf16_t* XB, bool write_xb, int tid, int bid, int G) {
    const int lane = tid & 63, wid = tid >> 6, gw = bid * 8 + wid, NGW = G * 8;
    f32x4 g[4], b[4];
#pragma unroll
    for (int j = 0; j < 4; ++j) { g[j] = *((const f32x4*)gain + lane + 64 * j); b[j] = *((const f32x4*)bias + lane + 64 * j); }
    for (int m = gw; m < MTOK; m += NGW) {
        const f32x4* yr = (const f32x4*)(Y + (size_t)m * DM) + lane;
        f32x4 v[4]; float s = 0.f;
#pragma unroll
        for (int j = 0; j < 4; ++j) { v[j] = yr[64 * j]; s += (v[j].x + v[j].y) + (v[j].z + v[j].w); }
        const float mean = wave_sum(s) * (1.f / DM); float s2 = 0.f;
#pragma unroll
        for (int j = 0; j < 4; ++j) { v[j] = v[j] - mean; s2 += (v[j].x * v[j].x + v[j].y * v[j].y) + (v[j].z * v[j].z + v[j].w * v[j].w); }
        const float rstd = 1.0f / sqrtf(wave_sum(s2) * (1.f / DM) + LN_EPS);
        f32x4* xr = (f32x4*)(X + (size_t)m * DM) + lane; u32x2* xb = (u32x2*)(XB + (size_t)m * DM) + lane;
#pragma unroll
        for (int j = 0; j < 4; ++j) { const f32x4 o = v[j] * rstd * g[j] + b[j]; xr[64 * j] = o;
            if (write_xb) xb[64 * j] = (u32x2){cvt_pk_bf16(o.x, o.y), cvt_pk_bf16(o.z, o.w)}; }
    }
}
__device__ __forceinline__ void unpack8(const u32x4 w, float (&f)[8]) { f[0] = bf_lo(w.x); f[1] = bf_hi(w.x); f[2] = bf_lo(w.y); f[3] = bf_hi(w.y); f[4] = bf_lo(w.z); f[5] = bf_hi(w.z); f[6] = bf_lo(w.w); f[7] = bf_hi(w.w); }
__device__ __forceinline__ u32x4 pack8(const float (&f)[8]) { u32x4 w; w.x = cvt_pk_bf16(f[0], f[1]); w.y = cvt_pk_bf16(f[2], f[3]); w.z = cvt_pk_bf16(f[4], f[5]); w.w = cvt_pk_bf16(f[6], f[7]); return w; }
__device__ __forceinline__ void pool_phase(const bf16_t* V, bf16_t* VP, int tid, int bid, int G) {
    const int NT = G * 512;
    for (int item = bid * 512 + tid; item < (MTOK / 32) * 256; item += NT) {
        const int c8 = (item & 255) * 8, t0 = (item >> 8) * 32, w = 2 << (c8 >> 9), ss = t0 & ~(SEQ - 1);
        float sum[8], f[8];
#pragma unroll
        for (int j = 0; j < 8; ++j) sum[j] = 0.f;
        for (int k = 1; k < w; ++k) { const int t = t0 - k; if (t >= ss) { unpack8(*(const u32x4*)(V + (size_t)t * DI + c8), f);
#pragma unroll
            for (int j = 0; j < 8; ++j) sum[j] += f[j]; } }
        for (int i = 0; i < 32; ++i) {
            const int t = t0 + i; unpack8(*(const u32x4*)(V + (size_t)t * DI + c8), f);
            const int cnt = (t - ss + 1) < w ? (t - ss + 1) : w; const float inv = 1.0f / (float)cnt; float o[8];
#pragma unroll
            for (int j = 0; j < 8; ++j) { sum[j] += f[j]; o[j] = sum[j] * inv - f[j]; }
            *(u32x4*)(VP + (size_t)t * DI + c8) = pack8(o);
            const int ts = t - w + 1;
            if (ts >= ss) { unpack8(*(const u32x4*)(V + (size_t)ts * DI + c8), f);
#pragma unroll
                for (int j = 0; j < 8; ++j) sum[j] -= f[j]; }
        }
    }
}
__device__ __forceinline__ void conv_phase(const bf16_t* MB, const bf16_t* BZ, bf16_t* RO, const float* cw, int tid, int bid, int G) {
    const int NT = G * 512;
    for (int item = bid * 512 + tid; item < (MTOK / 32) * 256; item += NT) {
        const int c8 = (item & 255) * 8, t0 = (item >> 8) * 32, ss = t0 & ~(SEQ - 1);
        float w0[8], w1[8], w2[8], m2[8], m1[8], m0[8], bz[8];
#pragma unroll
        for (int j = 0; j < 8; ++j) { w0[j] = cw[c8 + j]; w1[j] = cw[DI + c8 + j]; w2[j] = cw[2 * DI + c8 + j]; m2[j] = 0.f; m1[j] = 0.f; }
        if (t0 - 2 >= ss) unpack8(*(const u32x4*)(MB + (size_t)(t0 - 2) * DI + c8), m2);
        if (t0 - 1 >= ss) unpack8(*(const u32x4*)(MB + (size_t)(t0 - 1) * DI + c8), m1);
        for (int i = 0; i < 32; ++i) {
            const int t = t0 + i; unpack8(*(const u32x4*)(MB + (size_t)t * DI + c8), m0); unpack8(*(const u32x4*)(BZ + (size_t)t * DI + c8), bz);
            float o[8];
#pragma unroll
            for (int j = 0; j < 8; ++j) { o[j] = bz[j] * (w0[j] * m2[j] + w1[j] * m1[j] + w2[j] * m0[j]); m2[j] = m1[j]; m1[j] = m0[j]; }
            *(u32x4*)(RO + (size_t)t * DI + c8) = pack8(o);
        }
    }
}
constexpr int A2_ST_OFF = 8 * 16384;
static_assert(A2_ST_OFF + 1024 <= LDS_BYTES, "A2 LDS");
__device__ __forceinline__ void a2_phase(LAS unsigned char* lds, const bf16_t* PQ, bf16_t* QO, const bf16_t* GV, const f32x2* stats, const float* vgain, const float* vbias, const bf16_t* Wb, const float* rsum, const float* b_s, int tid, int bid, int G) {
    const int lane = tid & 63, wid = __builtin_amdgcn_readfirstlane(tid >> 6), fr = lane & 15, fq = lane >> 4, g = wid;
    LAS unsigned char* VT = lds + wid * 16384;
    LAS float* MU = (LAS float*)(lds + A2_ST_OFF); LAS float* RS = MU + 128;
    for (int ch = bid; ch < MTOK / 128; ch += G) {
        const int t0 = ch * 128;
        __syncthreads();
        if (tid < 128) { const f32x4* sp = (const f32x4*)(stats + (size_t)(t0 + tid) * 32); float s = 0.f, s2 = 0.f;
#pragma unroll
            for (int i = 0; i < 16; ++i) { const f32x4 v = sp[i]; s += v.x + v.z; s2 += v.y + v.w; }
            const float mu = s * (1.f / DI), var = s2 * (1.f / DI) - mu * mu; MU[tid] = mu; RS[tid] = 1.0f / sqrtf(var + LN_EPS); }
        __syncthreads();
        const unsigned vo_gv = (unsigned)((lane >> 3) * DI + (lane & 7) * 8) * 2u, vo_w = (unsigned)(fr * 128 + 8 * fq) * 2u, vo_pq = (unsigned)(fr * DI + 4 * fq) * 2u, vo_c = (unsigned)fq * 16u, vo_t = (unsigned)fr * 4u;
        float bsv[8], rsv[8];
#pragma unroll
        for (int tb = 0; tb < 8; ++tb) { bsv[tb] = *(const float*)((const char*)(b_s + g * 128 + 16 * tb) + vo_t); rsv[tb] = *(const float*)((const char*)(rsum + g * 128 + 16 * tb) + vo_t); }
#pragma unroll 1
        for (int qt = 0; qt < 4; ++qt) {
            const int cbase = g * 256 + qt * 64;
            { u32x4 raw[16];
#pragma unroll
                for (int i = 0; i < 16; ++i) raw[i] = *(const u32x4*)((const char*)(GV + (size_t)(t0 + 8 * i) * DI + cbase) + vo_gv);
#pragma unroll
                for (int i = 0; i < 16; ++i) { const int s = 8 * i + (lane >> 3); float f[8]; unpack8(raw[i], f); const float mu = MU[s], rs = RS[s];
#pragma unroll
                    for (int j = 0; j < 8; ++j) f[j] = (f[j] - mu) * rs;
                    *(LAS u32x4*)(VT + s * 128 + (lane & 7) * 16) = pack8(f); } }
            asm volatile("s_waitcnt lgkmcnt(0)" ::: "memory");
#pragma unroll 1
            for (int pass = 0; pass < 2; ++pass) {
                f32x4 acc[2][8];
#pragma unroll
                for (int cb = 0; cb < 2; ++cb)
#pragma unroll
                    for (int tb = 0; tb < 8; ++tb) acc[cb][tb] = (f32x4){0.f, 0.f, 0.f, 0.f};
#pragma unroll 1
                for (int ks = 0; ks < 4; ++ks) {
                    bf16x8 af[2];
#pragma unroll
                    for (int cb = 0; cb < 2; ++cb) {
                        LAS unsigned char* p = VT + (32 * ks + 8 * fq + (fr >> 2)) * 128 + (32 * pass + 16 * cb + 4 * (fr & 3)) * 2;
                        const s16x4 lo = __builtin_amdgcn_ds_read_tr16_b64_v4i16((LAS s16x4*)p);
                        const s16x4 hi = __builtin_amdgcn_ds_read_tr16_b64_v4i16((LAS s16x4*)(p + 4 * 128));
                        af[cb] = (bf16x8){lo[0], lo[1], lo[2], lo[3], hi[0], hi[1], hi[2], hi[3]};
                    }
#pragma unroll
                    for (int tb = 0; tb < 8; ++tb) {
                        if (32 * ks <= 16 * tb + 15) {
                            const bf16x8 bf = *(const bf16x8*)((const char*)(Wb + ((size_t)g * 128 + 16 * tb) * 128 + 32 * ks) + vo_w);
#pragma unroll
                            for (int cb = 0; cb < 2; ++cb) acc[cb][tb] = __builtin_amdgcn_mfma_f32_16x16x32_bf16(af[cb], bf, acc[cb][tb], 0, 0, 0);
                        }
                    }
                }
#pragma unroll
                for (int cb = 0; cb < 2; ++cb) { const int cu = cbase + 32 * pass + 16 * cb; const f32x4 gn = *(const f32x4*)((const char*)(vgain + cu) + vo_c), bb = *(const f32x4*)((const char*)(vbias + cu) + vo_c);
#pragma unroll
                    for (int tb = 0; tb < 8; ++tb) { const size_t eo = (size_t)(t0 + 16 * tb) * DI + cu; char* pp = (char*)(QO + eo) + vo_pq;
                        const u32x2 pv = *(const u32x2*)((const char*)(PQ + eo) + vo_pq); const f32x4 sv = gn * acc[cb][tb] + bb * rsv[tb] + bsv[tb];
                        *(u32x2*)pp = (u32x2){cvt_pk_bf16(sv[0] * bf_lo(pv.x), sv[1] * bf_hi(pv.x)), cvt_pk_bf16(sv[2] * bf_lo(pv.y), sv[3] * bf_hi(pv.y))}; } }
            }
            asm volatile("s_waitcnt lgkmcnt(0)" ::: "memory");
        }
    }
}

__device__ __forceinline__ void transpose_item(const float* W, int Nsrc, int src_col0, bf16_t* WT, int K, int dst_row0, int k0, LAS float* scr, int lane) {
#pragma unroll 8
    for (int i = 0; i < 32; ++i) { const int kk = 2 * i + (lane >> 5); scr[kk * 33 + (lane & 31)] = W[(size_t)(k0 + kk) * Nsrc + src_col0 + (lane & 31)]; }
    asm volatile("s_waitcnt lgkmcnt(0)" ::: "memory");
    const int c = lane & 7;
#pragma unroll
    for (int j = 0; j < 4; ++j) { const int n = (lane >> 3) + 8 * j; const LAS float* s = scr + (8 * c) * 33 + n;
        u32x4 o; o.x = cvt_pk_bf16(s[0 * 33], s[1 * 33]); o.y = cvt_pk_bf16(s[2 * 33], s[3 * 33]); o.z = cvt_pk_bf16(s[4 * 33], s[5 * 33]); o.w = cvt_pk_bf16(s[6 * 33], s[7 * 33]);
        *(u32x4*)(WT + (size_t)(dst_row0 + n) * K + k0 + 8 * c) = o; }
    asm volatile("s_waitcnt lgkmcnt(0)" ::: "memory");
}
__device__ __forceinline__ int map_src_col(int kind, int n) {
    if (kind == 0) return n;
    const int rb = n >> 7, pn = rb >> 1, half = rb & 1, r = n & 127;
    if (kind == 1) return pn < 16 ? (half ? 4096 : 0) + 128 * pn + r : 2048 + (n - 4096);
    return pn < 16 ? (half ? 4096 : 2048) + 128 * pn + r : (half ? 6144 : 0) + 128 * (pn - 16) + r;
}
struct Args { const float* in[28]; float* out; unsigned char* ws; int ph_lo, ph_hi; };

#define KIN(i) (*(const float* const __attribute__((address_space(4)))*)(karg + 8 * (i)))
typedef const unsigned char __attribute__((address_space(4)))* karg_t;
__device__ __forceinline__ void prologue_phase(karg_t karg, unsigned char* ws, LAS unsigned char* lds, int tid, int bid, int G) {
    const int lane = tid & 63, wid = tid >> 6, gw = bid * 8 + wid, NGW = G * 8;
    LAS float* scr = (LAS float*)(lds + wid * 16384);
    for (int mi = 0; mi < 12; ++mi) {
        const float* W; bf16_t* WT; int K, Nsrc, Ndst, kind = 0;
        switch (mi) {
            case 0:  W = KIN(1);  WT = (bf16_t*)(ws + WS_WA0);           K = DM; Nsrc = 3 * DI; Ndst = 3 * DI; kind = 1; break;
            case 1:  W = KIN(6);  WT = (bf16_t*)(ws + WS_WA0 + W_A_OUT); K = DI; Nsrc = DM; Ndst = DM; break;
            case 2:  W = KIN(9);  WT = (bf16_t*)(ws + WS_WB);            K = DM; Nsrc = 2 * DI; Ndst = 2 * DI; break;
            case 3:  W = KIN(10);                 WT = (bf16_t*)(ws + WS_WB_GRP);                   K = 512; Nsrc = 512; Ndst = 512; break;
            case 4:  W = KIN(10) + 1 * 512 * 512; WT = (bf16_t*)(ws + WS_WB_GRP) + 1 * 512 * 512;   K = 512; Nsrc = 512; Ndst = 512; break;
            case 5:  W = KIN(10) + 2 * 512 * 512; WT = (bf16_t*)(ws + WS_WB_GRP) + 2 * 512 * 512;   K = 512; Nsrc = 512; Ndst = 512; break;
            case 6:  W = KIN(10) + 3 * 512 * 512; WT = (bf16_t*)(ws + WS_WB_GRP) + 3 * 512 * 512;   K = 512; Nsrc = 512; Ndst = 512; break;
            case 7:  W = KIN(12); WT = (bf16_t*)(ws + WS_WB_OUT);        K = DI; Nsrc = DM; Ndst = DM; break;
            case 8:  W = KIN(15); WT = (bf16_t*)(ws + WS_WC);            K = DM; Nsrc = 4 * DI; Ndst = 4 * DI; kind = 2; break;
            case 9:  W = KIN(17); WT = (bf16_t*)(ws + WS_WC_OUT);        K = DI; Nsrc = DM; Ndst = DM; break;
            case 10: W = KIN(20); WT = (bf16_t*)(ws + WS_WA3);           K = DM; Nsrc = 3 * DI; Ndst = 3 * DI; kind = 1; break;
            default: W = KIN(25); WT = (bf16_t*)(ws + WS_WA3 + W_A_OUT); K = DI; Nsrc = DM; Ndst = DM; break;
        }
        const int nblk = Ndst / 32, nitems = (K / 64) * nblk;
        for (int it = gw; it < nitems; it += NGW) { const int kb = it / nblk, nb = it % nblk; transpose_item(W, Nsrc, map_src_col(kind, nb * 32), WT, K, nb * 32, kb * 64, scr, lane); }
    }
    for (int sel = 0; sel < 2; ++sel) {
        const float* w_s = sel == 0 ? KIN(4) : KIN(23); bf16_t* Wb = (bf16_t*)(ws + WS_WSB + sel * 262144); float* rsum = (float*)(ws + WS_RSUM + sel * 4096);
        for (int r = gw; r < 1024; r += NGW) { const int t = r & 127; float a = w_s[(size_t)r * 128 + lane], b = w_s[(size_t)r * 128 + lane + 64];
            a = lane <= t ? a : 0.f; b = lane + 64 <= t ? b : 0.f;
            Wb[(size_t)r * 128 + lane] = (bf16_t)(cvt_pk_bf16(a, 0.f) & 0xffffu); Wb[(size_t)r * 128 + lane + 64] = (bf16_t)(cvt_pk_bf16(b, 0.f) & 0xffffu);
            const float s = wave_sum(a + b); if (lane == 0) rsum[r] = s; }
    }
    const float* x = KIN(0); bf16_t* XB = (bf16_t*)(ws + WS_XB);
    for (size_t i = (size_t)bid * 512 + tid; i < (size_t)MTOK * DM / 8; i += (size_t)G * 512) {
        const f32x4 v0 = *((const f32x4*)x + 2 * i), v1 = *((const f32x4*)x + 2 * i + 1);
        *((u32x4*)XB + i) = (u32x4){cvt_pk_bf16(v0.x, v0.y), cvt_pk_bf16(v0.z, v0.w), cvt_pk_bf16(v1.x, v1.y), cvt_pk_bf16(v1.z, v1.w)};
    }
}

constexpr int N_PHASES = 21;
__host__ __device__ inline int li_of(int ph) { return ph == 0 ? 0 : (ph - 1) / 5; }
__host__ __device__ inline bool phase_empty(int ph) { if (ph == 0) return false; const int li = (ph - 1) / 5, s = (ph - 1) % 5; return s == 2 && (li % 3) != 1; }

#ifdef DUP_MASK
#define DUPOUT(p) (dummy_run ? DUMMY : (p))
#else
#define DUPOUT(p) (p)
#endif
__global__ void __launch_bounds__(512, 2) mk_fwd(Args a_unused) {
    extern __shared__ __attribute__((aligned(16))) unsigned char lds_raw[];
    LAS unsigned char* lds = (LAS unsigned char*)lds_raw;
    volatile LAS unsigned* bar_st = (volatile LAS unsigned*)(lds + LDS_BAR_OFF);
    if (threadIdx.x < 2) bar_st[threadIdx.x] = 0u;
    __syncthreads();
    XcdBarrier xbar; { karg_t k0 = (karg_t)__builtin_amdgcn_kernarg_segment_ptr(); unsigned char* ws0 = *(unsigned char* const __attribute__((address_space(4)))*)(k0 + 232); xbar = xcd_barrier_post((unsigned*)(ws0 + WS_BAR), bar_st); }
    int ph_lo, ph_hi; { karg_t k0 = (karg_t)__builtin_amdgcn_kernarg_segment_ptr(); ph_lo = *(const int __attribute__((address_space(4)))*)(k0 + 240); ph_hi = *(const int __attribute__((address_space(4)))*)(k0 + 244); }
    for (int ph = ph_lo, rep = 0; ph < ph_hi; ++ph) {
        if (phase_empty(ph)) continue;
        karg_t karg = (karg_t)__builtin_amdgcn_kernarg_segment_ptr(); asm volatile("" : "+s"(karg));
        int tid = threadIdx.x; asm volatile("" : "+v"(tid));
        int bid = blockIdx.x, G = gridDim.x; asm volatile("" : "+s"(bid), "+s"(G));
        float* out = *(float* const __attribute__((address_space(4)))*)(karg + 224);
        unsigned char* ws = *(unsigned char* const __attribute__((address_space(4)))*)(karg + 232);
        bf16_t* XB = (bf16_t*)(ws + WS_XB); bf16_t* BUFA = (bf16_t*)(ws + WS_BUFA); bf16_t* BUFB = (bf16_t*)(ws + WS_BUFB); bf16_t* BUFC = (bf16_t*)(ws + WS_BUFC);
        float* Y = (float*)(ws + WS_BUFA);
#ifdef DUP_MASK
        bf16_t* DUMMY = (li_of(ph) % 3 == 1) ? (bf16_t*)Y : BUFC;
        const int dslot = ph == 0 ? 5 : (ph - 1) % 5; const bool dup = ((DUP_MASK >> dslot) & 1) && (((DUP_MASK >> 6) & 1) || !((dslot == 1 && ((ph - 1) / 5) % 3 != 1) || dslot == 2));
        const bool dummy_run = dup && rep == 0 && ((DUP_MASK >> 6) & 1);
#endif
        f32x2* stats = (f32x2*)(ws + WS_STATS);
        __syncthreads();
        if (ph == 0) prologue_phase(karg, ws, lds, tid, bid, G);
        else {
            const int li = (ph - 1) / 5, slot = (ph - 1) % 5, kind = li % 3;
            const bf16_t* Win = (const bf16_t*)(ws + (li == 0 ? WS_WA0 : li == 1 ? WS_WB : li == 2 ? WS_WC : WS_WA3));
            const bf16_t* Wout = (const bf16_t*)(ws + (li == 0 ? WS_WA0 + W_A_OUT : li == 1 ? WS_WB_OUT : li == 2 ? WS_WC_OUT : WS_WA3 + W_A_OUT));
            if (slot == 0) {
                if (kind == 0) { Gemm g{XB, Win, DM, DM, DM}; StaticOrder<false> S; S.init(MTOK, 3 * DI, G, bid); EpiA1 E{BUFB, BUFA, stats}; gemm_phase(lds, g, S, E, tid); }
                else if (kind == 1) { Gemm g{XB, Win, DM, DM, DM}; StaticOrder<false> S; S.init(MTOK, 2 * DI, G, bid); EpiB1 E{BUFA, BUFB, KIN(11)}; gemm_phase(lds, g, S, E, tid); }
                else { Gemm g{XB, Win, DM, DM, DM}; StaticOrder<false> S; S.init(MTOK, 4 * DI, G, bid); EpiC1 E{BUFA, BUFB}; gemm_phase(lds, g, S, E, tid); }
            } else if (slot == 1) {
                const int b = li == 0 ? 0 : 19;
                if (kind == 0) a2_phase(lds, BUFB, DUPOUT(BUFB), BUFA, stats, KIN(2 + b), KIN(3 + b), (const bf16_t*)(ws + WS_WSB + (li == 0 ? 0 : 262144)), (const float*)(ws + WS_RSUM + (li == 0 ? 0 : 4096)), KIN(5 + b), tid, bid, G);
                else if (kind == 1) pool_phase(BUFA, BUFC, tid, bid, G);
                else conv_phase(BUFA, BUFB, DUPOUT(BUFB), KIN(16), tid, bid, G);
            } else if (slot == 2) {
                Gemm g{BUFC, (const bf16_t*)(ws + WS_WB_GRP), DI, 512, 512}; StaticOrder<true> S; S.init(MTOK, DI, G, bid); EpiBgrp E{BUFB, DUPOUT(BUFB)}; gemm_phase(lds, g, S, E, tid);
            } else if (slot == 3) {
                Gemm g{BUFB, Wout, DI, DI, DI}; StaticOrder<false> S; S.init(MTOK, DM, G, bid); EpiG2 E{li == 0 ? KIN(0) : (const float*)out, Y}; gemm_phase(lds, g, S, E, tid);
            } else {
                const int gi = li == 0 ? 7 : li == 1 ? 13 : li == 2 ? 18 : 26;
                ln_phase(Y, KIN(gi), KIN(gi + 1), out, XB, li != 3, tid, bid, G);
            }
        }
#ifdef DUP_MASK
        if (dup && rep == 0) { rep = 1; --ph; continue; } rep = 0;
#endif
        if (ph + 1 < ph_hi) { if (ph == 0) cg::this_grid().sync(); else xcd_barrier(xbar); }
#ifdef DUP_SYNC
        if (ph + 1 < ph_hi) { xcd_barrier(xbar); xcd_barrier(xbar); }
#endif
    }
}

extern "C" void kernel_launch(void* const* d_in, const int* in_sizes, int n_in, void* d_out, int out_size, void* d_ws, size_t ws_size, hipStream_t stream) {
    static int grid = 0;
    if (grid == 0) {
        if (n_in != 28 || in_sizes[0] != MTOK * DM || out_size != MTOK * DM || ws_size < WS_END) { fprintf(stderr, "kernel_launch: unexpected shapes: n_in %d in0 %d out %d ws %zu (need %zu)\n", n_in, n_in > 0 ? in_sizes[0] : -1, out_size, ws_size, (size_t)WS_END); grid = -1; return; }
        int dev = 0, cus = 0, per_cu = 0;
        if (hipGetDevice(&dev) != hipSuccess || hipDeviceGetAttribute(&cus, hipDeviceAttributeMultiprocessorCount, dev) != hipSuccess) { fprintf(stderr, "kernel_launch: device query failed\n"); grid = -1; return; }
        if (hipFuncSetAttribute((const void*)mk_fwd, hipFuncAttributeMaxDynamicSharedMemorySize, LDS_BYTES) != hipSuccess) { fprintf(stderr, "kernel_launch: hipFuncSetAttribute failed\n"); grid = -1; return; }
        if (hipOccupancyMaxActiveBlocksPerMultiprocessor(&per_cu, (const void*)mk_fwd, 512, LDS_BYTES) != hipSuccess || per_cu < 1) { fprintf(stderr, "kernel_launch: occupancy query says %d blocks/CU\n", per_cu); per_cu = 1; }
        (void)hipGetLastError();
        grid = cus * per_cu;
        fprintf(stderr, "kernel_launch: grid %d (cus %d x %d)\n", grid, cus, per_cu);
    }
    if (grid < 0) return;
    if (hipMemsetAsync((char*)d_ws + WS_BAR, 0, WS_BAR_BYTES, stream) != hipSuccess) { fprintf(stderr, "kernel_launch: memset of the barrier words failed\n"); return; }
    Args a{};
    for (int i = 0; i < 28; ++i) a.in[i] = (const float*)d_in[i];
    a.out = (float*)d_out; a.ws = (unsigned char*)d_ws;
#if MK_MULTI
    for (int ph = 0; ph < N_PHASES; ++ph) {
        if (phase_empty(ph)) continue;
        a.ph_lo = ph; a.ph_hi = ph + 1;
        hipLaunchKernelGGL(mk_fwd, dim3(grid), dim3(512), LDS_BYTES, stream, a);
    }
#else
    a.ph_lo = 0; a.ph_hi = N_PHASES;
    void* args[] = {&a};
    hipError_t e = hipLaunchCooperativeKernel((const void*)mk_fwd, dim3(grid), dim3(512), args, LDS_BYTES, stream);
    if (e != hipSuccess) fprintf(stderr, "kernel_launch: cooperative launch failed: %s (grid %d)\n", hipGetErrorString(e), grid);
#endif
}
```
